# Optimizing an MI355X kernel written in HIP

```python
import jax, jax.numpy as jnp
from jax import lax
import numpy as np

D_MODEL = 1024
BATCH = 8
SEQ = 2048
DEPTH = 4

CTX_LEN = 256
GRID_W = 64
N_MIXERS = 2
N_HEADS = 16
N_KV_HEADS = 4
HEAD_DIM = D_MODEL // N_HEADS
KV_GROUP = N_HEADS // N_KV_HEADS
ROPE_PAIRS_PER_AXIS = HEAD_DIM // 4
ROPE_THETA = 10000.0
Q_BLOCK = 128
CONV_WIDTH = 31
CONV_PAD = CONV_WIDTH // 2
D_FF = (((8 * D_MODEL + 2) // 3 + 255) // 256) * 256
N_CONV_LAYERS = (DEPTH + N_MIXERS - 1) // N_MIXERS
N_ATTN_LAYERS = DEPTH // N_MIXERS
N_MOD = 6
EPS = 1e-6

kernel_name = "hybrid_conv_gqa_diffusion_trunk"


def rmsnorm(x, g):
    xf = x.astype(jnp.float32)
    y = xf * lax.rsqrt(jnp.mean(xf * xf, axis=-1, keepdims=True) + EPS)
    return (y * g.astype(jnp.float32)).astype(x.dtype)


def layernorm(x, g, b):
    xf = x.astype(jnp.float32)
    mu = jnp.mean(xf, axis=-1, keepdims=True)
    var = jnp.mean(jnp.square(xf - mu), axis=-1, keepdims=True)
    y = (xf - mu) * lax.rsqrt(var + EPS)
    return (y * g.astype(jnp.float32) + b.astype(jnp.float32)).astype(x.dtype)


def axial_rope_tables(row, col):
    freqs = ROPE_THETA ** (-jnp.arange(ROPE_PAIRS_PER_AXIS, dtype=jnp.float32) / ROPE_PAIRS_PER_AXIS)
    ang = jnp.concatenate([row.astype(jnp.float32)[:, None] * freqs[None, :],
                           col.astype(jnp.float32)[:, None] * freqs[None, :]], axis=-1)
    return jnp.cos(ang), jnp.sin(ang)


def apply_rope(x, cos, sin):
    B, S, H, Dh = x.shape
    xr = x.astype(jnp.float32).reshape(B, S, H, Dh // 2, 2)
    x0, x1 = xr[..., 0], xr[..., 1]
    c = cos[None, :, None, :]
    s = sin[None, :, None, :]
    out = jnp.stack([x0 * c - x1 * s, x0 * s + x1 * c], axis=-1)
    return out.reshape(B, S, H, Dh).astype(x.dtype)


def conv_module(h, w_pw1, b_pw1, w_dw, b_dw, ln_g, ln_b, w_pw2, b_pw2):
    u = h @ w_pw1 + b_pw1
    a, gt = jnp.split(u, 2, axis=-1)
    u = a * jax.nn.sigmoid(gt)
    u = lax.conv_general_dilated(
        u, w_dw[:, None, :].astype(u.dtype), window_strides=(1,),
        padding=[(CONV_PAD, CONV_PAD)], dimension_numbers=("NWC", "WIO", "NWC"),
        feature_group_count=u.shape[-1]) + b_dw
    u = jax.nn.silu(layernorm(u, ln_g, ln_b))
    return u @ w_pw2 + b_pw2


def gqa_sdpa(q, k, v):
    B, Q, H, Dh = q.shape
    qg = q.reshape(B, Q, N_KV_HEADS, KV_GROUP, Dh)
    s = jnp.einsum("bqkgd,bskd->bkgqs", qg, k).astype(jnp.float32) * (Dh ** -0.5)
    p = jax.nn.softmax(s, axis=-1).astype(v.dtype)
    o = jnp.einsum("bkgqs,bskd->bqkgd", p, v)
    return o.reshape(B, Q, H * Dh)


def attention_module(hx, hc, wq, wk, wv, wo, q_g, k_g, cos, sin, need_ctx):
    B, S, _ = hx.shape
    L = hc.shape[1]
    qx = apply_rope(rmsnorm((hx @ wq).reshape(B, S, N_HEADS, HEAD_DIM), q_g), cos, sin)
    kx = apply_rope(rmsnorm((hx @ wk).reshape(B, S, N_KV_HEADS, HEAD_DIM), k_g), cos, sin)
    vx = (hx @ wv).reshape(B, S, N_KV_HEADS, HEAD_DIM)
    kc = rmsnorm((hc @ wk).reshape(B, L, N_KV_HEADS, HEAD_DIM), k_g)
    vc = (hc @ wv).reshape(B, L, N_KV_HEADS, HEAD_DIM)
    k_all = jnp.concatenate([kx, kc], axis=1)
    v_all = jnp.concatenate([vx, vc], axis=1)
    n_blk = S // Q_BLOCK
    qb = qx.reshape(B, n_blk, Q_BLOCK, N_HEADS, HEAD_DIM).transpose(1, 0, 2, 3, 4)
    ob = lax.map(lambda q: gqa_sdpa(q, k_all, v_all), qb)
    yx = ob.transpose(1, 0, 2, 3).reshape(B, S, N_HEADS * HEAD_DIM) @ wo
    yc = None
    if need_ctx:
        qc = rmsnorm((hc @ wq).reshape(B, L, N_HEADS, HEAD_DIM), q_g)
        yc = gqa_sdpa(qc, kc, vc) @ wo
    return yx, yc


def swiglu(h, w1, w3, w2):
    return (jax.nn.silu(h @ w1) * (h @ w3)) @ w2


def setup_inputs(seed: int = 0) -> dict:
    key = jax.random.key(seed)
    ks = jax.random.split(key, 32)
    D = D_MODEL

    def nrm(k, shape, scale):
        return jax.random.normal(k, shape, jnp.float32) * scale

    NC, NA = N_CONV_LAYERS, N_ATTN_LAYERS
    return {
        "x": nrm(ks[0], (BATCH, SEQ, D), 1.0),
        "c": nrm(ks[1], (BATCH, D), 1.0),
        "ctx": nrm(ks[2], (BATCH, CTX_LEN, D), 1.0),
        "c_ctx": nrm(ks[3], (D,), 1.0),
        "w_mod": nrm(ks[4], (DEPTH, D, N_MOD * D), 0.5 * D ** -0.5),
        "b_mod": nrm(ks[5], (DEPTH, N_MOD * D), 0.01),
        "norm_g": 1.0 + nrm(ks[6], (DEPTH, 4, D), 0.05),
        "conv_w_pw1": nrm(ks[7], (NC, D, 2 * D), D ** -0.5),
        "conv_b_pw1": nrm(ks[8], (NC, 2 * D), 0.01),
        "conv_w_dw": nrm(ks[9], (NC, CONV_WIDTH, D), CONV_WIDTH ** -0.5),
        "conv_b_dw": nrm(ks[10], (NC, D), 0.01),
        "conv_ln_g": 1.0 + nrm(ks[11], (NC, D), 0.05),
        "conv_ln_b": nrm(ks[12], (NC, D), 0.01),
        "conv_w_pw2": nrm(ks[13], (NC, D, D), D ** -0.5),
        "conv_b_pw2": nrm(ks[14], (NC, D), 0.01),
        "attn_wq": nrm(ks[15], (NA, D, N_HEADS * HEAD_DIM), D ** -0.5),
        "attn_wk": nrm(ks[16], (NA, D, N_KV_HEADS * HEAD_DIM), D ** -0.5),
        "attn_wv": nrm(ks[17], (NA, D, N_KV_HEADS * HEAD_DIM), D ** -0.5),
        "attn_wo": nrm(ks[18], (NA, N_HEADS * HEAD_DIM, D), (N_HEADS * HEAD_DIM) ** -0.5),
        "attn_q_g": 1.0 + nrm(ks[19], (NA, HEAD_DIM), 0.05),
        "attn_k_g": 1.0 + nrm(ks[20], (NA, HEAD_DIM), 0.05),
        "ffn_w1": nrm(ks[21], (DEPTH, D, D_FF), D ** -0.5),
        "ffn_w3": nrm(ks[22], (DEPTH, D, D_FF), D ** -0.5),
        "ffn_w2": nrm(ks[23], (DEPTH, D_FF, D), D_FF ** -0.5),
    }


def reference(x, c, ctx, c_ctx, w_mod, b_mod, norm_g,
              conv_w_pw1, conv_b_pw1, conv_w_dw, conv_b_dw, conv_ln_g, conv_ln_b, conv_w_pw2, conv_b_pw2,
              attn_wq, attn_wk, attn_wv, attn_wo, attn_q_g, attn_k_g,
              ffn_w1, ffn_w3, ffn_w2):
    B, S, D = x.shape
    rows = S // GRID_W
    row = jnp.repeat(jnp.arange(rows), GRID_W)
    col = jnp.tile(jnp.arange(GRID_W), rows)
    cos, sin = axial_rope_tables(row, col)
    silu_c = jax.nn.silu(c)
    silu_cc = jax.nn.silu(c_ctx)

    for i in range(DEPTH):
        need_ctx = i < DEPTH - 1
        mod_x = (silu_c @ w_mod[i] + b_mod[i])[:, None, :]
        mod_c = silu_cc @ w_mod[i] + b_mod[i]
        sh_x, sc_x, g_x, shf_x, scf_x, gf_x = jnp.split(mod_x, N_MOD, axis=-1)
        sh_c, sc_c, g_c, shf_c, scf_c, gf_c = jnp.split(mod_c, N_MOD, axis=-1)

        hx = rmsnorm(x, norm_g[i, 0]) * (1.0 + sc_x) + sh_x
        hc = rmsnorm(ctx, norm_g[i, 0]) * (1.0 + sc_c) + sh_c
        if i % N_MIXERS == 0:
            j = i // N_MIXERS
            cp = (conv_w_pw1[j], conv_b_pw1[j], conv_w_dw[j], conv_b_dw[j],
                  conv_ln_g[j], conv_ln_b[j], conv_w_pw2[j], conv_b_pw2[j])
            yx = conv_module(hx, *cp)
            yc = conv_module(hc, *cp) if need_ctx else None
        else:
            j = i // N_MIXERS
            yx, yc = attention_module(hx, hc, attn_wq[j], attn_wk[j], attn_wv[j], attn_wo[j],
                                      attn_q_g[j], attn_k_g[j], cos, sin, need_ctx)
        x = x + g_x * rmsnorm(yx, norm_g[i, 1])
        if need_ctx:
            ctx = ctx + g_c * rmsnorm(yc, norm_g[i, 1])

        fx = rmsnorm(x, norm_g[i, 2]) * (1.0 + scf_x) + shf_x
        x = x + gf_x * rmsnorm(swiglu(fx, ffn_w1[i], ffn_w3[i], ffn_w2[i]), norm_g[i, 3])
        if need_ctx:
            fc = rmsnorm(ctx, norm_g[i, 2]) * (1.0 + scf_c) + shf_c
            ctx = ctx + gf_c * rmsnorm(swiglu(fc, ffn_w1[i], ffn_w3[i], ffn_w2[i]), norm_g[i, 3])
    return x
```

```cpp
#define MK_MULTI 0
#include <hip/hip_runtime.h>
#include <hip/hip_cooperative_groups.h>
#include <cstdio>
#include <cstdint>
namespace pg8 {
#define PG8_LAS __attribute__((address_space(3)))
typedef unsigned short bf16_t;
typedef short bf16x8 __attribute__((ext_vector_type(8)));
typedef float f32x4 __attribute__((ext_vector_type(4)));
typedef unsigned u32x4 __attribute__((ext_vector_type(4)));
constexpr int BM = 256, BK = 64, HALF = 128, HTB = HALF * BK * 2  , STAGE_BYTES = 8 * HTB, NXCD = 8, WGM = 8;

__host__ __device__ __forceinline__ int lds_byte(int r, int c) { const int st = (r >> 4) * 2 + (c >> 5), rr = r & 15, cc = c & 31, ob = rr * 64 + cc * 2; return st * 1024 + (ob ^ (((ob >> 9) & 1) << 5)); }
__host__ __device__ __forceinline__ void stage_rc(int b, int& R, int& C) { const int st = b / 1024, sb = b % 1024, swz = sb ^ (((sb >> 9) & 1) << 5); R = (st >> 1) * 16 + swz / 64; C = (st & 1) * 32 + (swz % 64) / 2; }
__host__ __device__ __forceinline__ int perm32(int rho) { const int n = rho >> 4, i = rho & 15; return 8 * (i >> 2) + 4 * n + (i & 3); }

struct Unit { int pm, pn; };
struct Gemm { const bf16_t* A; const bf16_t* Bt; int M, N, K; };

struct StaticOrder {
    int nM, nN, nwg, G, c;
    __host__ __device__ void init(int M, int N, int G_, int c_) { nM = M / BM; nN = N / BM; nwg = nM * nN; G = G_; c = c_; }
    __host__ __device__ bool next(int i, Unit& u) const {
        const long L = (long)i * G + c; if (L >= nwg) return false;
        int wgid = (int)L; { const int q = nwg / NXCD, r = nwg % NXCD, xcd = wgid % NXCD, off = wgid / NXCD; wgid = (xcd < r ? xcd * (q + 1) : r * (q + 1) + (xcd - r) * q) + off; }
        const int nig = WGM * nN, gid = wgid / nig, fm = gid * WGM, gsz = (nM - fm) < WGM ? (nM - fm) : WGM;
        u.pm = fm + ((wgid % nig) % gsz); u.pn = (wgid % nig) / gsz; return true;
    }
    __device__ __forceinline__ void a_ready(const Unit&) const {}
    __device__ __forceinline__ void done(const Unit&) const {}
};

__device__ __forceinline__ unsigned cvt_pk_bf16(float lo, float hi) { unsigned r; asm volatile("v_cvt_pk_bf16_f32 %0, %1, %2" : "=v"(r) : "v"(lo), "v"(hi)); return r; }
typedef float f32x2 __attribute__((ext_vector_type(2)));
struct TileOrder {
    int nM, nN, nmain, nextra, xpm0, xpn0, xw, G, c;
    __device__ void init(int nM_, int nN_, int nextra_, int xpm0_, int xpn0_, int xw_, int G_, int c_) { nM = nM_; nN = nN_; nmain = nM_ * nN_; nextra = nextra_; xpm0 = xpm0_; xpn0 = xpn0_; xw = xw_; G = G_; c = c_; }
    __device__ bool next(int i, Unit& u) const {
        const long L = (long)i * G + c; if (L >= nmain + nextra) return false;
        if (L >= nmain) { const int e = (int)L - nmain; u.pm = xpm0 + e / xw; u.pn = xpn0 + e % xw; return true; }
        int wgid = (int)L; const int nwg = nmain; { const int q = nwg / NXCD, r = nwg % NXCD, xcd = wgid % NXCD, off = wgid / NXCD; wgid = (xcd < r ? xcd * (q + 1) : r * (q + 1) + (xcd - r) * q) + off; }
        const int nig = WGM * nN, gid = wgid / nig, fm = gid * WGM, gsz = (nM - fm) < WGM ? (nM - fm) : WGM;
        u.pm = fm + ((wgid % nig) % gsz); u.pn = (wgid % nig) / gsz; return true;
    }
    __device__ __forceinline__ void a_ready(const Unit&) const {}
    __device__ __forceinline__ void done(const Unit&) const {}
};
__device__ __forceinline__ float sigmoidf_fast(float x) { return __builtin_amdgcn_rcpf(1.0f + __expf(-x)); }
template <int MODE> struct EpiGate {
    static constexpr bool PERM = true, AFTER_DRAIN = false;
    bf16_t* O; int ldc; const float* bias;
    __device__ __forceinline__ void operator()(const f32x4 (&acc)[2][2][4][2], const Unit& u, int wr, int wc, int fr, int fq) const {
        const int row0 = u.pm * BM + wr * 64 + fr, col0 = u.pn * 128 + wc * 32 + 8 * fq;
        f32x4 ba[2], bb[2];
#pragma unroll
        for (int n = 0; n < 2; ++n) { if (MODE == 0) { ba[n] = *(const f32x4*)(bias + col0 + 4 * n); bb[n] = *(const f32x4*)(bias + 1024 + col0 + 4 * n); } else { ba[n] = (f32x4){0.f, 0.f, 0.f, 0.f}; bb[n] = ba[n]; } }
#pragma unroll
        for (int ai = 0; ai < 2; ++ai)
#pragma unroll
            for (int m = 0; m < 4; ++m) {
                float o[8];
#pragma unroll
                for (int n = 0; n < 2; ++n) { const f32x4 a = acc[ai][0][m][n] + ba[n], b = acc[ai][1][m][n] + bb[n];
#pragma unroll
                    for (int e = 0; e < 4; ++e) o[4 * n + e] = (MODE == 0) ? a[e] * sigmoidf_fast(b[e]) : a[e] * sigmoidf_fast(a[e]) * b[e]; }
                u32x4 w; w.x = cvt_pk_bf16(o[0], o[1]); w.y = cvt_pk_bf16(o[2], o[3]); w.z = cvt_pk_bf16(o[4], o[5]); w.w = cvt_pk_bf16(o[6], o[7]);
                *(u32x4*)(O + (size_t)(row0 + ai * HALF + m * 16) * ldc + col0) = w;
            }
    }
};
struct EpiY {
    static constexpr bool PERM = true, AFTER_DRAIN = false;
    float* Y; float* SSQ; const float* bias;
    __device__ __forceinline__ void operator()(const f32x4 (&acc)[2][2][4][2], const Unit& u, int wr, int wc, int fr, int fq) const {
        const int row0 = u.pm * BM + wr * 64 + fr, col0 = u.pn * BM + wc * 32 + 8 * fq;
        f32x4 bv[2][2];
#pragma unroll
        for (int bj = 0; bj < 2; ++bj)
#pragma unroll
            for (int n = 0; n < 2; ++n) bv[bj][n] = bias ? *(const f32x4*)(bias + col0 + bj * HALF + 4 * n) : (f32x4){0.f, 0.f, 0.f, 0.f};
#pragma unroll
        for (int ai = 0; ai < 2; ++ai)
#pragma unroll
            for (int m = 0; m < 4; ++m) { const int row = row0 + ai * HALF + m * 16; float* yp = Y + (size_t)row * 1024 + col0; float ss = 0.f;
#pragma unroll
                for (int bj = 0; bj < 2; ++bj)
#pragma unroll
                    for (int n = 0; n < 2; ++n) { const f32x4 v = acc[ai][bj][m][n] + bv[bj][n]; *(f32x4*)(yp + bj * HALF + 4 * n) = v; ss += (v[0] * v[0] + v[1] * v[1]) + (v[2] * v[2] + v[3] * v[3]); }
                ss += __shfl_xor(ss, 16); ss += __shfl_xor(ss, 32);
                if (fq == 0) SSQ[(size_t)row * 16 + u.pn * 4 + wc] = ss; }
    }
};
struct EpiQKV {
    static constexpr bool PERM = true, AFTER_DRAIN = false;
    bf16_t *Q, *Kb, *Vb; const float *qg, *kg; const float* rope;
    __device__ __forceinline__ void operator()(const f32x4 (&acc)[2][2][4][2], const Unit& u, int wr, int wc, int fr, int fq) const {
        const int pn = u.pn, row0 = u.pm * BM + wr * 64 + fr; const bool isx = u.pm < 64;
        if (pn == 5) {
#pragma unroll
            for (int ai = 0; ai < 2; ++ai)
#pragma unroll
                for (int m = 0; m < 4; ++m) { bf16_t* dst = Vb + (size_t)(row0 + ai * HALF + m * 16) * 256 + wc * 64 + 8 * fq;
#pragma unroll
                    for (int bj = 0; bj < 2; ++bj) { const f32x4 a = acc[ai][bj][m][0], b = acc[ai][bj][m][1]; u32x4 w; w.x = cvt_pk_bf16(a[0], a[1]); w.y = cvt_pk_bf16(a[2], a[3]); w.z = cvt_pk_bf16(b[0], b[1]); w.w = cvt_pk_bf16(b[2], b[3]);
                        *(u32x4*)(dst + 32 * bj) = w; } }
            return;
        }
        const bool isq = pn < 4; const float* gp = (isq ? qg : kg) + 8 * fq; const float osc = isq ? 0.125f * 1.4426950408889634f : 1.0f;
        f32x4 gv[2][2];
#pragma unroll
        for (int bj = 0; bj < 2; ++bj)
#pragma unroll
            for (int n = 0; n < 2; ++n) gv[bj][n] = *(const f32x4*)(gp + 32 * bj + 4 * n) * osc;
#pragma unroll
        for (int ai = 0; ai < 2; ++ai) {
            f32x4 cs0[2] = {(f32x4){1.f, 0.f, 1.f, 0.f}, (f32x4){1.f, 0.f, 1.f, 0.f}};
            if (isx) { const int posr = 4 * (u.pm & 7) + 2 * ai + wr; const float* rp = rope + (size_t)(posr * 16 + 4 * fq) * 2; cs0[0] = *(const f32x4*)rp; cs0[1] = *(const f32x4*)(rp + 4); }
#pragma unroll
            for (int m = 0; m < 4; ++m) {
                const int row = row0 + ai * HALF + m * 16;
                float ss = 0.f;
#pragma unroll
                for (int bj = 0; bj < 2; ++bj)
#pragma unroll
                    for (int n = 0; n < 2; ++n) { const f32x4 v = acc[ai][bj][m][n]; ss += (v[0] * v[0] + v[1] * v[1]) + (v[2] * v[2] + v[3] * v[3]); }
                ss += __shfl_xor(ss, 16); ss += __shfl_xor(ss, 32);
                const float inv = __builtin_amdgcn_rsqf(ss * (1.0f / 64.0f) + 1e-6f);
                f32x4 cs1[2] = {(f32x4){1.f, 0.f, 1.f, 0.f}, (f32x4){1.f, 0.f, 1.f, 0.f}};
                if (isx) { const int posc = 16 * m + fr; const float* rp = rope + (size_t)(posc * 16 + 4 * fq) * 2; cs1[0] = *(const f32x4*)rp; cs1[1] = *(const f32x4*)(rp + 4); }
                bf16_t* dst = isq ? (Q + (size_t)row * 1024 + (4 * pn + wc) * 64 + 8 * fq) : (Kb + (size_t)row * 256 + wc * 64 + 8 * fq);
#pragma unroll
                for (int bj = 0; bj < 2; ++bj) { float o[8];
#pragma unroll
                    for (int n = 0; n < 2; ++n) { const f32x4 v = acc[ai][bj][m][n] * inv * gv[bj][n]; const f32x4 cs = bj == 0 ? cs0[n] : cs1[n];
                        o[4 * n + 0] = v[0] * cs[0] - v[1] * cs[1]; o[4 * n + 1] = v[0] * cs[1] + v[1] * cs[0];
                        o[4 * n + 2] = v[2] * cs[2] - v[3] * cs[3]; o[4 * n + 3] = v[2] * cs[3] + v[3] * cs[2]; }
                    u32x4 w; w.x = cvt_pk_bf16(o[0], o[1]); w.y = cvt_pk_bf16(o[2], o[3]); w.z = cvt_pk_bf16(o[4], o[5]); w.w = cvt_pk_bf16(o[6], o[7]);
                    *(u32x4*)(dst + 32 * bj) = w; }
            }
        }
    }
};

template <class Epi, class Sched, bool ALIGN_EPI = false, bool SP2 = false>
__device__ __forceinline__ void gemm_phase(PG8_LAS unsigned char* lds, const Gemm g, const Sched& S, const Epi& E) {
    int tid_ = threadIdx.x; asm volatile("" : "+v"(tid_)); const int tid = tid_, wid = __builtin_amdgcn_readfirstlane(tid >> 6), lane = tid & 63, wr = wid >> 2, wc = wid & 3, fr = lane & 15, fq = lane >> 4;
    const int K = g.K, nt = K / BK;
    unsigned voffA[2], voffB[2];
#pragma unroll
    for (int i = 0; i < 2; ++i) { int R, C; stage_rc(tid * 16 + i * 8192, R, C); const int Rb = Epi::PERM ? ((R & ~31) + perm32(R & 31)) : R;
        voffA[i] = (unsigned)(R * K + C) * 2u; voffB[i] = (unsigned)(Rb * K + C) * 2u; }
    const size_t kstep = (size_t)(BK * 2);
    const size_t hstep = (size_t)HALF * K * 2;
    const size_t tstep = 2 * hstep;
    const unsigned ldsw = (unsigned)wid * 1024u;
    const int aoff = lds_byte(wr * 64 + fr, fq * 8), boff = lds_byte(wc * 32 + fr, fq * 8);
#define PG8_SA(b, h) (((b) * 2 + (h)) * HTB)
#define PG8_SB(b, h) ((4 + (b) * 2 + (h)) * HTB)
#define PG8_STAGE(bufoff, gbase, voff) do { _Pragma("unroll") for (int _i = 0; _i < 2; ++_i) \
        __builtin_amdgcn_global_load_lds((const unsigned*)((const char*)(gbase) + (voff)[_i]), (PG8_LAS unsigned*)(lds + (bufoff) + ldsw + _i * 8192), 16, 0, 0); } while (0)
#define PG8_LDA(dst, b, h) do { _Pragma("unroll") for (int m = 0; m < 4; ++m) _Pragma("unroll") for (int k = 0; k < 2; ++k) dst[m][k] = *(const PG8_LAS bf16x8*)(lds + PG8_SA(b, h) + aoff + m * 2048 + k * 1024); } while (0)
#define PG8_LDB(dst, b, h) do { _Pragma("unroll") for (int n = 0; n < 2; ++n) _Pragma("unroll") for (int k = 0; k < 2; ++k) dst[n][k] = *(const PG8_LAS bf16x8*)(lds + PG8_SB(b, h) + boff + n * 2048 + k * 1024); } while (0)
#define PG8_MMA(ai, bj, At, Bt) do { __builtin_amdgcn_s_setprio(1); _Pragma("unroll") for (int m = 0; m < 4; ++m) _Pragma("unroll") for (int n = 0; n < 2; ++n) _Pragma("unroll") for (int k = 0; k < 2; ++k) \
        acc[ai][bj][m][n] = __builtin_amdgcn_mfma_f32_16x16x32_bf16(Bt[n][k], At[m][k], acc[ai][bj][m][n], 0, 0, 0); __builtin_amdgcn_s_setprio(0); } while (0)
#define PG8_WAIT_V(n) asm volatile("s_waitcnt vmcnt(" #n ")" ::: "memory")
#define PG8_WAIT_L(n) asm volatile("s_waitcnt lgkmcnt(" #n ")" ::: "memory")
#define PG8_BAR __builtin_amdgcn_s_barrier()
#define PG8_SCHED __builtin_amdgcn_sched_barrier(0)
    Unit cur, nxt; int ui = 0;
    if (!S.next(0, cur)) return;
    f32x4 acc[2][2][4][2];
#pragma unroll
    for (int a = 0; a < 2; ++a)
#pragma unroll
        for (int b = 0; b < 2; ++b)
#pragma unroll
            for (int m = 0; m < 4; ++m)
#pragma unroll
                for (int n = 0; n < 2; ++n) acc[a][b][m][n] = (f32x4){0.f, 0.f, 0.f, 0.f};
    bf16x8 At[4][2], B0[2][2], B1[2][2];
    const char* cA = (const char*)g.A + (size_t)cur.pm * tstep; const char* cB = (const char*)g.Bt + (size_t)cur.pn * tstep;
    S.a_ready(cur);
    if constexpr (SP2) {
        PG8_STAGE(PG8_SB(0, 0), cB, voffB); PG8_STAGE(PG8_SB(0, 1), cB + hstep, voffB); PG8_STAGE(PG8_SA(0, 0), cA, voffA); PG8_STAGE(PG8_SA(0, 1), cA + hstep, voffA);
        if (wr == 1) PG8_BAR;
        PG8_WAIT_V(2); PG8_BAR;
        PG8_STAGE(PG8_SB(1, 0), cB + kstep, voffB); PG8_STAGE(PG8_SA(1, 0), cA + kstep, voffA); PG8_STAGE(PG8_SB(1, 1), cB + hstep + kstep, voffB);
        PG8_WAIT_V(6); PG8_BAR;
    } else {
        PG8_STAGE(PG8_SB(0, 0), cB, voffB); PG8_STAGE(PG8_SA(0, 0), cA, voffA); PG8_STAGE(PG8_SB(0, 1), cB + hstep, voffB); PG8_STAGE(PG8_SA(0, 1), cA + hstep, voffA);
        if (wr == 1) PG8_BAR;
        PG8_WAIT_V(4); PG8_BAR;
        PG8_STAGE(PG8_SB(1, 0), cB + kstep, voffB); PG8_STAGE(PG8_SA(1, 0), cA + kstep, voffA); PG8_STAGE(PG8_SB(1, 1), cB + hstep + kstep, voffB);
        PG8_WAIT_V(6); PG8_BAR;
    }
    for (;;) {
        const bool has_next = S.next(ui + 1, nxt);
        const char* nA = has_next ? (const char*)g.A + (size_t)nxt.pm * tstep : cA; const char* nB = has_next ? (const char*)g.Bt + (size_t)nxt.pn * tstep : cB;
        for (int t = 0; t < nt; t += 2) {
            const bool last = (t == nt - 2);
            const char* a1 = cA + (size_t)(t + 1) * kstep;
            const char* a2 = last ? nA : cA + (size_t)(t + 2) * kstep; const char* b2 = last ? nB : cB + (size_t)(t + 2) * kstep;
            const char* a3 = a2 + kstep; const char* b3 = b2 + kstep;
            if (last && has_next) S.a_ready(nxt);
            if constexpr (SP2) {
            PG8_LDB(B0, 0, 0); PG8_LDB(B1, 0, 1); PG8_SCHED; PG8_LDA(At, 0, 0); PG8_STAGE(PG8_SA(1, 1), a1 + hstep, voffA);
            PG8_WAIT_V(8); PG8_WAIT_L(0); PG8_BAR; PG8_MMA(0, 0, At, B0); PG8_MMA(0, 1, At, B1); PG8_BAR; PG8_SCHED;
            PG8_LDA(At, 0, 1); PG8_STAGE(PG8_SB(0, 0), b2, voffB); PG8_STAGE(PG8_SB(0, 1), b2 + hstep, voffB); PG8_STAGE(PG8_SA(0, 0), a2, voffA);
            PG8_WAIT_V(8); PG8_WAIT_L(0); PG8_BAR; PG8_MMA(1, 0, At, B0); PG8_MMA(1, 1, At, B1); PG8_BAR; PG8_SCHED;
            PG8_LDB(B0, 1, 0); PG8_LDB(B1, 1, 1); PG8_SCHED; PG8_LDA(At, 1, 0); PG8_STAGE(PG8_SA(0, 1), a2 + hstep, voffA);
            PG8_WAIT_V(8); PG8_WAIT_L(0); PG8_BAR; PG8_MMA(0, 0, At, B0); PG8_MMA(0, 1, At, B1); PG8_BAR; PG8_SCHED;
            PG8_LDA(At, 1, 1); PG8_STAGE(PG8_SB(1, 0), b3, voffB); PG8_STAGE(PG8_SB(1, 1), b3 + hstep, voffB); PG8_STAGE(PG8_SA(1, 0), a3, voffA);
            PG8_WAIT_V(8); PG8_WAIT_L(0); PG8_BAR; PG8_MMA(1, 0, At, B0); PG8_MMA(1, 1, At, B1); PG8_BAR; PG8_SCHED;
            } else {
            PG8_LDB(B0, 0, 0); PG8_SCHED; PG8_LDA(At, 0, 0); PG8_STAGE(PG8_SA(1, 1), a1 + hstep, voffA);
            PG8_WAIT_L(8); PG8_BAR; PG8_WAIT_L(0); PG8_MMA(0, 0, At, B0); PG8_BAR; PG8_SCHED;
            PG8_LDB(B1, 0, 1); PG8_STAGE(PG8_SB(0, 0), b2, voffB);
            PG8_BAR; PG8_WAIT_L(0); PG8_MMA(0, 1, At, B1); PG8_BAR;
            PG8_LDA(At, 0, 1); PG8_STAGE(PG8_SA(0, 0), a2, voffA);
            PG8_BAR; PG8_WAIT_L(0); PG8_MMA(1, 0, At, B0); PG8_BAR; PG8_SCHED;
            PG8_STAGE(PG8_SB(0, 1), b2 + hstep, voffB);
            PG8_WAIT_V(6); PG8_BAR; PG8_MMA(1, 1, At, B1); PG8_BAR;
            PG8_LDB(B0, 1, 0); PG8_SCHED; PG8_LDA(At, 1, 0); PG8_STAGE(PG8_SA(0, 1), a2 + hstep, voffA);
            PG8_WAIT_L(8); PG8_BAR; PG8_WAIT_L(0); PG8_MMA(0, 0, At, B0); PG8_BAR; PG8_SCHED;
            PG8_LDB(B1, 1, 1); PG8_STAGE(PG8_SB(1, 0), b3, voffB);
            PG8_BAR; PG8_WAIT_L(0); PG8_MMA(0, 1, At, B1); PG8_BAR;
            PG8_LDA(At, 1, 1); PG8_STAGE(PG8_SA(1, 0), a3, voffA);
            PG8_BAR; PG8_WAIT_L(0); PG8_MMA(1, 0, At, B0); PG8_BAR; PG8_SCHED;
            PG8_STAGE(PG8_SB(1, 1), b3 + hstep, voffB);
            PG8_WAIT_V(6); PG8_BAR; PG8_MMA(1, 1, At, B1); PG8_BAR;
            }
        }
        if constexpr (ALIGN_EPI) { if (wr == 0) PG8_BAR; }
        if constexpr (!Epi::AFTER_DRAIN) { E(acc, cur, wr, wc, fr, fq); S.done(cur); }
        if (!has_next) break;
#pragma unroll
        for (int a = 0; a < 2; ++a)
#pragma unroll
            for (int b = 0; b < 2; ++b)
#pragma unroll
                for (int m = 0; m < 4; ++m)
#pragma unroll
                    for (int n = 0; n < 2; ++n) acc[a][b][m][n] = (f32x4){0.f, 0.f, 0.f, 0.f};
        cur = nxt; cA = nA; cB = nB; ++ui;
        if constexpr (ALIGN_EPI) { if (wr == 1) PG8_BAR; }
    }
    PG8_WAIT_V(0);
    if constexpr (!ALIGN_EPI) { if (wr == 0) PG8_BAR; }
    PG8_BAR;
    if constexpr (Epi::AFTER_DRAIN) { E.fused(acc, cur, wr, wc, fr, fq, lds, wid, lane); S.done(cur); }
#undef PG8_SA
#undef PG8_SB
#undef PG8_STAGE
#undef PG8_LDA
#undef PG8_LDB
#undef PG8_MMA
#undef PG8_WAIT_V
#undef PG8_WAIT_L
#undef PG8_BAR
#undef PG8_SCHED
}
}
#include <hip/hip_bf16.h>
#include <cmath>
namespace attn_body {
using bf16=__hip_bfloat16;
using bf16x8=__attribute__((ext_vector_type(8)))short;
using s16x4=__attribute__((ext_vector_type(4)))short;
using f32x16=__attribute__((ext_vector_type(16)))float;
using u32x4=__attribute__((ext_vector_type(4)))unsigned;
constexpr int D=64,DM=1024,KVP=256;
constexpr int NW=8,QBLK=32,QB=QBLK*NW,KVBLK=64;
constexpr int ATTN_PITCH=DM, ATTN_UNIT_ROWS=QB;
__device__ __forceinline__ int crow(int r,int hi){return (r&3)+8*(r>>2)+4*hi;}
#define SBAR() __builtin_amdgcn_sched_barrier(0)
__device__ __forceinline__ void cmask(f32x16&p0,f32x16&p1,int jb,int qrel,int hi){
  const float NEG=-INFINITY; int kb=64*jb+4*hi;
  #pragma unroll
  for(int r=0;r<16;++r){int kv=kb+(r&3)+8*(r>>2); if(kv>qrel)p0[r]=NEG; if(kv+32>qrel)p1[r]=NEG;}
}

constexpr int NSLOT=3, SLOTB=8192;
constexpr int LDS_K=0, LDS_V=NSLOT*SLOTB, LDS_WS=2*NSLOT*SLOTB, LDS_OST=LDS_WS+NW*64*4, LDS_BYTES=LDS_OST+NW*4096;
constexpr float C2=0.125f*1.4426950408889634f;
__device__ __forceinline__ void glds16(const void*gsrc,unsigned lds_dst){unsigned keep;
  asm volatile("s_mov_b32 %0, m0\n\ts_mov_b32 m0, %2\n\ts_nop 0\n\tglobal_load_lds_dwordx4 %1, off\n\ts_mov_b32 m0, %0":"=&s"(keep):"v"(gsrc),"s"(lds_dst):"memory");}
__device__ __forceinline__ float max3f(float a,float b,float c){float r;asm("v_max3_f32 %0, %1, %2, %3":"=v"(r):"v"(a),"v"(b),"v"(c));return r;}
__device__ __forceinline__ float max2f(float a,float b){float r;asm("v_max_f32_e32 %0, %1, %2":"=v"(r):"v"(a),"v"(b));return r;}
__device__ __forceinline__ float fadd_s(float a,float b){float r;asm("v_add_f32_e32 %0, %1, %2":"=v"(r):"v"(a),"v"(b));return r;}
__device__ __forceinline__ float fsub_s(float a,float b){float r;asm("v_sub_f32_e32 %0, %1, %2":"=v"(r):"v"(a),"v"(b));return r;}
typedef float f32x2_t __attribute__((ext_vector_type(2))); typedef __bf16 bf16x2_t __attribute__((ext_vector_type(2)));
__device__ __forceinline__ unsigned cvtpk_s(float lo,float hi){f32x2_t v={lo,hi};bf16x2_t b=__builtin_convertvector(v,bf16x2_t);return __builtin_bit_cast(unsigned,b);}
#define WAIT_BAR(N) asm volatile("s_waitcnt vmcnt(" #N ") lgkmcnt(0)\n\ts_barrier":::"memory")

__device__ __forceinline__ void qkt(f32x16&p0,f32x16&p1,const char*Kslot,const bf16x8*qr,const f32x16&negm,int r32,int hi){
  const char*kb=Kslot+hi*1024+r32*16;
  #pragma unroll
  for(int d0=0;d0<4;++d0){
    const bf16x8 b0=*reinterpret_cast<const bf16x8*>(kb+d0*2048);
    const bf16x8 b1=*reinterpret_cast<const bf16x8*>(kb+d0*2048+512);
    if(d0==0){p0=__builtin_amdgcn_mfma_f32_32x32x16_bf16(b0,qr[0],negm,0,0,0);p1=__builtin_amdgcn_mfma_f32_32x32x16_bf16(b1,qr[0],negm,0,0,0);}
    else{p0=__builtin_amdgcn_mfma_f32_32x32x16_bf16(b0,qr[d0],p0,0,0,0);p1=__builtin_amdgcn_mfma_f32_32x32x16_bf16(b1,qr[d0],p1,0,0,0);}}
}
typedef __attribute__((address_space(3))) const char* lds_cptr;
typedef short v4i16_t __attribute__((ext_vector_type(4)));
__device__ __forceinline__ void kload8(bf16x8*kf,lds_cptr kp){
  kf[0]=*(const __attribute__((address_space(3))) bf16x8*)(kp);      kf[1]=*(const __attribute__((address_space(3))) bf16x8*)(kp+512);
  kf[2]=*(const __attribute__((address_space(3))) bf16x8*)(kp+2048); kf[3]=*(const __attribute__((address_space(3))) bf16x8*)(kp+2560);
  kf[4]=*(const __attribute__((address_space(3))) bf16x8*)(kp+4096); kf[5]=*(const __attribute__((address_space(3))) bf16x8*)(kp+4608);
  kf[6]=*(const __attribute__((address_space(3))) bf16x8*)(kp+6144); kf[7]=*(const __attribute__((address_space(3))) bf16x8*)(kp+6656);
}
__device__ __forceinline__ void kload2(bf16x8*kf,lds_cptr kp,int j){ kf[2*j]=*(const __attribute__((address_space(3))) bf16x8*)(kp+j*2048); kf[2*j+1]=*(const __attribute__((address_space(3))) bf16x8*)(kp+j*2048+512); }
__device__ __forceinline__ s16x4 vtr(lds_cptr p){ return __builtin_bit_cast(s16x4,__builtin_amdgcn_ds_read_tr16_b64_v4i16((__attribute__((address_space(3))) v4i16_t*)p)); }
__device__ __forceinline__ float rowmax(const f32x16&p0,const f32x16&p1){
  float a=max3f(p0[0],p0[1],p1[0]),b=max3f(p0[2],p0[3],p1[1]);a=max3f(a,p1[2],p1[3]);
  #pragma unroll
  for(int r=4;r<16;r+=4){a=max3f(a,p0[r],p0[r+1]);b=max3f(b,p0[r+2],p0[r+3]);a=max3f(a,p1[r],p1[r+1]);b=max3f(b,p1[r+2],p1[r+3]);}
  const float m=max2f(a,b);
  auto rr=__builtin_amdgcn_permlane32_swap(__float_as_uint(m),__float_as_uint(m),false,false);
  return max2f(__uint_as_float(rr[0]),__uint_as_float(rr[1]));
}
__device__ __forceinline__ void pv(f32x16*o,int vb,bf16x8 pa0,bf16x8 pa1,bf16x8 pa2,bf16x8 pa3){
  #pragma unroll
  for(int d0=0;d0<2;++d0){s16x4 lo[4],hi[4];
    #pragma unroll
    for(int ks=0;ks<4;++ks){
      asm volatile("ds_read_b64_tr_b16 %0,%1 offset:%c2":"=&v"(lo[ks]):"v"(vb),"i"(d0*4096+ks*1024):"memory");
      asm volatile("ds_read_b64_tr_b16 %0,%1 offset:%c2":"=&v"(hi[ks]):"v"(vb),"i"(d0*4096+ks*1024+512):"memory");}
    asm volatile("s_waitcnt lgkmcnt(0)":::"memory");SBAR();
    #define PK(k) (bf16x8){lo[k][0],lo[k][1],lo[k][2],lo[k][3],hi[k][0],hi[k][1],hi[k][2],hi[k][3]}
    o[d0]=__builtin_amdgcn_mfma_f32_32x32x16_bf16(pa0,PK(0),o[d0],0,0,0);
    o[d0]=__builtin_amdgcn_mfma_f32_32x32x16_bf16(pa1,PK(1),o[d0],0,0,0);
    o[d0]=__builtin_amdgcn_mfma_f32_32x32x16_bf16(pa2,PK(2),o[d0],0,0,0);
    o[d0]=__builtin_amdgcn_mfma_f32_32x32x16_bf16(pa3,PK(3),o[d0],0,0,0);
    #undef PK
  }
}

#ifndef ATTN_STORE16
#define ATTN_STORE16(p,v) (*(u32x4*)(p)=(v))
#endif
template<int THRL> __device__ __forceinline__ void attn_unit(const bf16*Qb,const bf16*__restrict__ Kh,const bf16*__restrict__ Vh,bf16*Ob,const int NT,const int NTX,const long xr0,const long cr0,char*shm){
  int tid_=threadIdx.x; asm volatile("":"+v"(tid_)); const int tid=tid_,lane=tid&63,r32=lane&31,hi=lane>>5; const int wid=__builtin_amdgcn_readfirstlane(tid>>6);
  const bf16*Qw=Qb+(long)(wid*QBLK)*DM;
  const unsigned lds0=(unsigned)(uintptr_t)shm;
  float*wsf=(float*)(shm+LDS_WS)+wid*64;
  const bf16*ksrc=Kh+(long)lane*KVP+wid*8;
  const bf16*vsrc=Vh+(long)(16*(wid&3)+(lane>>2))*KVP+(wid>>2)*32+(lane&3)*8;
  const unsigned kdst=lds0+LDS_K+wid*1024, vdst=lds0+LDS_V+wid*1024;
  #define KVROW(t) (((t)<NTX)?(xr0+(long)(t)*KVBLK):(cr0+(long)((t)-NTX)*KVBLK))
  #define DMA_K(t,slot) glds16(ksrc+KVROW(t)*KVP,(unsigned)__builtin_amdgcn_readfirstlane(kdst+(slot)))
  #define DMA_V(t,slot) glds16(vsrc+KVROW(t)*KVP,(unsigned)__builtin_amdgcn_readfirstlane(vdst+(slot)))
  const int vb0=(int)(lds0+LDS_V)+((lane>>4)&1)*32+(lane&3)*8+(4*hi+((lane&15)>>2))*64;
  const char*Kbase=shm+LDS_K; bf16x8 kf[8];
  const lds_cptr shm3=(lds_cptr)shm; const lds_cptr kp0=shm3+LDS_K+hi*1024+r32*16; const lds_cptr vp0=shm3+LDS_V+((lane>>4)&1)*32+(lane&3)*8+(4*hi+((lane&15)>>2))*64;
  DMA_K(0,0);DMA_V(0,0);DMA_K(1,SLOTB);
  bf16x8 qr[4];
  #pragma unroll
  for(int d0=0;d0<4;++d0)qr[d0]=*reinterpret_cast<const bf16x8*>(&Qw[(long)r32*DM+d0*16+hi*8]);
  float mhat=0.f,l_reg=0.f;f32x16 o[2];o[0]=f32x16{};o[1]=f32x16{};f32x16 negm=f32x16{};asm volatile("":"+v"(negm));
  #define CMASK(P0,P1,t) do{}while(0)
  bool resc=false;
  #define START(P0,P1) do{ const float rm=rowmax(P0,P1); resc=false; \
    { const float dl=rm; mhat=fadd_s(mhat,dl); \
      _Pragma("unroll") for(int r=0;r<16;++r){P0[r]=fsub_s(P0[r],dl);P1[r]=fsub_s(P1[r],dl);} \
      _Pragma("unroll") for(int r=0;r<16;++r)negm[r]=-mhat; asm volatile("":"+v"(negm)); } \
    _Pragma("unroll") for(int r=0;r<16;++r)P0[r]=__builtin_amdgcn_exp2f(P0[r]); }while(0)
  #define RESC() do{ if(resc){ asm volatile("s_waitcnt lgkmcnt(0)":::"memory"); \
      _Pragma("unroll") for(int d_=0;d_<2;++d_) _Pragma("unroll") for(int r=0;r<16;++r)o[d_][r]*=wsf[crow(r,hi)]; } }while(0)
  f32x16 pA0,pA1,pB0,pB1;
  int sl_prev=0,sl_cur=0,sl_next=SLOTB;
  #define ROT() do{sl_prev=sl_cur;sl_cur=sl_next;sl_next=(sl_next==(NSLOT-1)*SLOTB)?0:sl_next+SLOTB;}while(0)
  DMA_K(2,2*SLOTB);
  WAIT_BAR(3);
  qkt(pA0,pA1,Kbase,qr,negm,r32,hi);asm volatile("s_nop 15\n\ts_nop 7":"+v"(pA0),"+v"(pA1));CMASK(pA0,pA1,0);
  START(pA0,pA1);
  _Pragma("unroll") for(int r=0;r<16;++r)pA1[r]=__builtin_amdgcn_exp2f(pA1[r]);
  WAIT_BAR(0);
  DMA_K(3,0);DMA_V(1,SLOTB);
  ROT();
  kload8(kf,kp0+sl_cur);
  WAIT_BAR(2);
  s16x4 vlo[8],vhi[8]; u32x4 pw0,pw1,pw2,pw3;
  #define PKW(P,B) cvtpk_s(P[B],P[B+1])
  #define PAF(k) __builtin_bit_cast(bf16x8,pw##k)
  #define VFR(i) (bf16x8){vlo[i][0],vlo[i][1],vlo[i][2],vlo[i][3],vhi[i][0],vhi[i][1],vhi[i][2],vhi[i][3]}
  #define PIN(x) asm volatile("":"+v"(x))
  #define MX3(a,b,c) __builtin_fmaxf(__builtin_fmaxf((a),(b)),(c))
  #define GAPA(MF,A0,A1,A2,A3,W0,W1,PW) do{ MF; sacc+=A0; sacc+=A1; sacc+=A2; sacc+=A3; PIN(sacc); W0; W1; PIN(PW); SBAR(); }while(0)
  #define EX(v) __builtin_amdgcn_exp2f(v)
  #define GAPB(MF,X,B) do{ MF; X[B]=EX(X[B]); X[B+1]=EX(X[B+1]); X[B+2]=EX(X[B+2]); X[B+3]=EX(X[B+3]); PIN(X); SBAR(); }while(0)
  #define VRD(i) do{ vlo[i]=vtr(vp_+(((i)>>2)*4096+((i)&3)*1024)); vhi[i]=vtr(vp_+(((i)>>2)*4096+((i)&3)*1024+512)); }while(0)
  #define KRD(G,j) do{ if(G){ kload2(kf,kp0+sl_next,j); SBAR(); } }while(0)
  #define STEP(C0,C1,P0,P1,t,GK,GV,GL) do{ SBAR(); \
    const lds_cptr vp_=vp0+sl_prev; \
    VRD(0); SBAR(); float sacc=(P0[0]+P0[1]); \
    GAPA(C0=__builtin_amdgcn_mfma_f32_32x32x16_bf16(kf[0],qr[0],negm,0,0,0), P0[2],P0[3],P0[4],P0[5],     pw0[0]=PKW(P0,0), pw0[1]=PKW(P0,2), pw0); \
    VRD(4); SBAR(); GAPA(C1=__builtin_amdgcn_mfma_f32_32x32x16_bf16(kf[1],qr[0],negm,0,0,0), P0[6],P0[7],P0[8],P0[9],     pw0[2]=PKW(P0,4), pw0[3]=PKW(P0,6), pw0); \
    VRD(1); SBAR(); GAPA(C0=__builtin_amdgcn_mfma_f32_32x32x16_bf16(kf[2],qr[1],C0,0,0,0),   P0[10],P0[11],P0[12],P0[13], pw1[0]=PKW(P0,8), pw1[1]=PKW(P0,10), pw1); \
    VRD(5); SBAR(); GAPA(C1=__builtin_amdgcn_mfma_f32_32x32x16_bf16(kf[3],qr[1],C1,0,0,0),   P0[14],P0[15],P1[0],P1[1],   pw1[2]=PKW(P0,12),pw1[3]=PKW(P0,14), pw1); \
    VRD(2); SBAR(); GAPA(C0=__builtin_amdgcn_mfma_f32_32x32x16_bf16(kf[4],qr[2],C0,0,0,0),   P1[2],P1[3],P1[4],P1[5],     pw2[0]=PKW(P1,0), pw2[1]=PKW(P1,2), pw2); \
    VRD(6); SBAR(); GAPA(C1=__builtin_amdgcn_mfma_f32_32x32x16_bf16(kf[5],qr[2],C1,0,0,0),   P1[6],P1[7],P1[8],P1[9],     pw2[2]=PKW(P1,4), pw2[3]=PKW(P1,6), pw2); \
    VRD(3); SBAR(); GAPA(C0=__builtin_amdgcn_mfma_f32_32x32x16_bf16(kf[6],qr[3],C0,0,0,0),   P1[10],P1[11],P1[12],P1[13], pw3[0]=PKW(P1,8), pw3[1]=PKW(P1,10), pw3); \
    VRD(7); SBAR(); GAPA(C1=__builtin_amdgcn_mfma_f32_32x32x16_bf16(kf[7],qr[3],C1,0,0,0),   P1[14],P1[15],0.f,0.f,       pw3[2]=PKW(P1,12),pw3[3]=PKW(P1,14), pw3); \
    l_reg+=sacc; \
    if(GK){DMA_K((t)+3,sl_cur);} if(GV){DMA_V((t)+1,sl_next);} \
    CMASK(C0,C1,t); \
    { float a=MX3(C0[0],C0[1],C1[0]),b=MX3(C0[2],C0[3],C1[1]); a=MX3(a,C1[2],C1[3]); \
      _Pragma("unroll") for(int r=4;r<16;r+=4){a=MX3(a,C0[r],C0[r+1]);b=MX3(b,C0[r+2],C0[r+3]);a=MX3(a,C1[r],C1[r+1]);b=MX3(b,C1[r+2],C1[r+3]);} \
      float rm=__builtin_fmaxf(a,b); { auto rr=__builtin_amdgcn_permlane32_swap(__float_as_uint(rm),__float_as_uint(rm),false,false); rm=__builtin_fmaxf(__uint_as_float(rr[0]),__uint_as_float(rr[1])); } \
      resc=false; \
      if(__builtin_expect(__any(rm>(float)THRL),0)){ const float dl=__builtin_fmaxf(rm,0.f); mhat+=dl; \
        _Pragma("unroll") for(int r=0;r<16;++r){C0[r]-=dl;C1[r]-=dl;} \
        _Pragma("unroll") for(int r=0;r<16;++r)negm[r]=-mhat; asm volatile("":"+v"(negm)); \
        const float f=__builtin_amdgcn_exp2f(-dl); l_reg*=f; if(hi==0)wsf[r32]=f; resc=true; } } \
    SBAR(); \
    GAPB(o[0]=__builtin_amdgcn_mfma_f32_32x32x16_bf16(PAF(0),VFR(0),o[0],0,0,0), C0,0); \
    GAPB(o[1]=__builtin_amdgcn_mfma_f32_32x32x16_bf16(PAF(0),VFR(4),o[1],0,0,0), C0,4); \
    KRD(GL,0); GAPB(o[0]=__builtin_amdgcn_mfma_f32_32x32x16_bf16(PAF(1),VFR(1),o[0],0,0,0), C0,8); \
    KRD(GL,1); GAPB(o[1]=__builtin_amdgcn_mfma_f32_32x32x16_bf16(PAF(1),VFR(5),o[1],0,0,0), C0,12); \
    KRD(GL,2); GAPB(o[0]=__builtin_amdgcn_mfma_f32_32x32x16_bf16(PAF(2),VFR(2),o[0],0,0,0), C1,0); \
    KRD(GL,3); GAPB(o[1]=__builtin_amdgcn_mfma_f32_32x32x16_bf16(PAF(2),VFR(6),o[1],0,0,0), C1,4); \
    GAPB(o[0]=__builtin_amdgcn_mfma_f32_32x32x16_bf16(PAF(3),VFR(3),o[0],0,0,0), C1,8); \
    GAPB(o[1]=__builtin_amdgcn_mfma_f32_32x32x16_bf16(PAF(3),VFR(7),o[1],0,0,0), C1,12); \
    }while(0)
  int t=1;
  #undef CMASK
  #define CMASK(P0,P1,t) do{}while(0)
  for(;t+5<NT;t+=2){
    STEP(pB0,pB1,pA0,pA1,t,true,true,true);     WAIT_BAR(2); RESC(); ROT();
    STEP(pA0,pA1,pB0,pB1,t+1,true,true,true);   WAIT_BAR(2); RESC(); ROT();
  }
  #undef CMASK
  #define CMASK(P0,P1,t) do{}while(0)
  #define ENDW(tt) do{ if((tt)+3<NT){WAIT_BAR(2);} else if((tt)+2<NT){WAIT_BAR(1);} else {WAIT_BAR(0);} }while(0)
  for(;t+1<NT;t+=2){
    STEP(pB0,pB1,pA0,pA1,t,(t+3<NT),(t+1<NT),(t+1<NT));       ENDW(t);   RESC(); ROT();
    STEP(pA0,pA1,pB0,pB1,t+1,(t+4<NT),(t+2<NT),(t+2<NT));     ENDW(t+1); RESC(); ROT();
  }
  STEP(pB0,pB1,pA0,pA1,NT-1,false,false,false); RESC();
  { float sacc=pB0[0]+pB0[1]; _Pragma("unroll") for(int r=2;r<16;++r)sacc+=pB0[r]; _Pragma("unroll") for(int r=0;r<16;++r)sacc+=pB1[r]; l_reg+=sacc;
    pw0=(u32x4){PKW(pB0,0),PKW(pB0,2),PKW(pB0,4),PKW(pB0,6)};pw1=(u32x4){PKW(pB0,8),PKW(pB0,10),PKW(pB0,12),PKW(pB0,14)};pw2=(u32x4){PKW(pB1,0),PKW(pB1,2),PKW(pB1,4),PKW(pB1,6)};pw3=(u32x4){PKW(pB1,8),PKW(pB1,10),PKW(pB1,12),PKW(pB1,14)};
    SBAR(); pv(o,vb0+sl_cur,PAF(0),PAF(1),PAF(2),PAF(3)); }
  #undef PKW
  #undef PAF
  #undef VFR
  #undef PIN
  #undef MX3
  #undef GAPA
  #undef GAPB
  #undef EX
  #undef VRD
  #undef KRD
  #undef STEP
  #undef ENDW
  {auto rr=__builtin_amdgcn_permlane32_swap(__float_as_uint(l_reg),__float_as_uint(l_reg),false,false);l_reg=__uint_as_float(rr[0])+__uint_as_float(rr[1]);}
  if(hi==0)wsf[32+r32]=l_reg;asm volatile("s_waitcnt lgkmcnt(0)":::"memory");
  float rli[16];
  #pragma unroll
  for(int r=0;r<16;++r)rli[r]=__builtin_amdgcn_rcpf(wsf[32+crow(r,hi)]);
  bf16*Ow=Ob+(long)(wid*QBLK)*DM;
  { bf16*stg=(bf16*)(shm+LDS_OST)+wid*2048;
    #pragma unroll
    for(int r=0;r<16;++r){const int orow=crow(r,hi);
      #pragma unroll
      for(int d0=0;d0<2;++d0)stg[orow*64+d0*32+r32]=__float2bfloat16(o[d0][r]*rli[r]);}
    asm volatile("s_waitcnt lgkmcnt(0)":::"memory");
    #pragma unroll
    for(int i=0;i<4;++i){const int row=i*8+(lane>>3),ch=lane&7; const u32x4 v=*(const u32x4*)(stg+row*64+ch*8); ATTN_STORE16(Ow+(long)row*DM+ch*8,v);} }
  asm volatile("s_waitcnt lgkmcnt(0)\n\ts_barrier":::"memory");
  #undef DMA_K
  #undef KVROW
  #undef DMA_V
  #undef CMASK
  #undef START
  #undef RESC
  #undef ROT
}
#undef SBAR
#undef WAIT_BAR
}
#ifndef DIS
#define DIS 0
#endif
namespace cg = cooperative_groups;
#define LAS __attribute__((address_space(3)))
typedef unsigned short bf16;
typedef unsigned v4u __attribute__((ext_vector_type(4)));
typedef unsigned v2u __attribute__((ext_vector_type(2)));
typedef float f32x4 __attribute__((ext_vector_type(4)));
typedef float f32x2 __attribute__((ext_vector_type(2)));
constexpr int NWAVES = 8;
constexpr int DM = 1024, NBATCH = 8, SEQ = 2048, CTXL = 256, MX = NBATCH * SEQ, MC = NBATCH * CTXL, MT = MX + MC;
constexpr int DFF = 2816, DEPTH = 4, NMODV = 6, MODW = NMODV * DM;
constexpr float EPS = 1e-6f;
constexpr size_t MiB = 1u << 20;
constexpr size_t WS_CTL = 0, WS_MOD = 1 * MiB, WS_ROPE = 2 * MiB, WS_SSQ = 3 * MiB, WS_PW1T = 5 * MiB, WS_PW2T = 13 * MiB, WS_QKVT = 17 * MiB, WS_WOT = 23 * MiB, WS_W13T = 27 * MiB, WS_W2T = 71 * MiB,
                 WS_X = 93 * MiB, WS_Y = 165 * MiB, WS_H = 237 * MiB, WS_G = 273 * MiB, WS_END = 372 * MiB;
constexpr size_t WS_U = WS_G, WS_CV = WS_G + 36 * MiB, WS_KB = WS_G + 36 * MiB, WS_VB = WS_G + 45 * MiB;
constexpr int RING_BYTES = 131072, LDS_BYTES = 147456;
constexpr int N_PHASES = 2 + 7 * DEPTH;

__device__ __forceinline__ unsigned f2bf(float f) { unsigned u = __builtin_bit_cast(unsigned, f); return (u + 0x7fffu + ((u >> 16) & 1u)) >> 16; }
__device__ __forceinline__ unsigned pk2(float lo, float hi) { return f2bf(lo) | (f2bf(hi) << 16); }
__device__ __forceinline__ float wave_sum(float v) {
#pragma unroll
    for (int o = 1; o < 64; o <<= 1) v += __shfl_xor(v, o);
    return v;
}
struct Args { const float* in[24]; float* out; unsigned char* ws; int ph_lo, ph_hi; };
struct Frame {
    LAS unsigned char* lds;
    int tid, lane, wave, vcu, G;
    float* out; unsigned char* ws;
};
__device__ __forceinline__ void transpose_item(const float* W, int N, bf16* WT, int KT, int dst_row0, LAS float* scr, int k0, int n0, int lane) {
#pragma unroll 8
    for (int i = 0; i < 32; ++i) { const int kk = 2 * i + (lane >> 5); scr[kk * 33 + (lane & 31)] = W[(size_t)(k0 + kk) * N + n0 + (lane & 31)]; }
    asm volatile("s_waitcnt lgkmcnt(0)" ::: "memory");
    const int c = lane & 7;
#pragma unroll
    for (int j = 0; j < 4; ++j) { const int n = (lane >> 3) + 8 * j; const LAS float* s = scr + (8 * c) * 33 + n;
        v4u o; o.x = pk2(s[0 * 33], s[1 * 33]); o.y = pk2(s[2 * 33], s[3 * 33]); o.z = pk2(s[4 * 33], s[5 * 33]); o.w = pk2(s[6 * 33], s[7 * 33]);
        *(v4u*)(WT + (size_t)(dst_row0 + n) * KT + k0 + 8 * c) = o; }
    asm volatile("s_waitcnt lgkmcnt(0)" ::: "memory");
}
__device__ __forceinline__ int map_row(int kind, int n0) {
    if (kind == 0) return n0;
    if (kind == 1) { const int bj = n0 >> 10, rem = n0 & 1023; return 256 * (rem >> 7) + 128 * bj + (rem & 127); }
    if (kind == 2) return 256 * (n0 >> 7) + (n0 & 127);
    if (kind == 3) return 256 * (n0 >> 7) + 128 + (n0 & 127);
    const int head = n0 >> 6, bj = (n0 >> 5) & 1;
    if (kind == 4) return 256 * (head >> 2) + 128 * bj + 32 * (head & 3);
    if (kind == 5) return 1024 + 128 * bj + 32 * head;
    return 1280 + 128 * bj + 32 * head;
}
__device__ __forceinline__ void p0_prologue(Frame& F, const Args& args) {
    LAS float* scr = (LAS float*)(F.lds + F.wave * 16384);
    const int gw = F.vcu * NWAVES + F.wave, NGW = F.G * NWAVES;
    unsigned char* ws = F.ws;
    constexpr int I_PW1 = 16 * 64, I_SQ = 16 * 32, I_KV = 16 * 8, I_W1 = 16 * 88, I_W2 = 44 * 32;
    constexpr int I_CONV = I_PW1 + I_SQ, I_ATT = 2 * I_SQ + 2 * I_KV, I_FFN = 2 * I_W1 + I_W2;
    constexpr int NITEMS = 2 * I_CONV + 2 * I_ATT + 4 * I_FFN;
    for (int it = gw; it < NITEMS; it += NGW) {
        int r = it; const float* W; int K, N, kind; bf16* WT;
        if (r < 2 * I_CONV) { const int j = r / I_CONV; r -= j * I_CONV;
            if (r < I_PW1) { W = args.in[7] + (size_t)j * DM * 2 * DM; K = DM; N = 2 * DM; kind = 1; WT = (bf16*)(ws + WS_PW1T) + (size_t)j * 2 * DM * DM; }
            else { r -= I_PW1; W = args.in[13] + (size_t)j * DM * DM; K = DM; N = DM; kind = 0; WT = (bf16*)(ws + WS_PW2T) + (size_t)j * DM * DM; } }
        else if (r < 2 * I_CONV + 2 * I_ATT) { r -= 2 * I_CONV; const int j = r / I_ATT; r -= j * I_ATT; K = DM;
            bf16* qkv = (bf16*)(ws + WS_QKVT) + (size_t)j * 1536 * DM;
            if (r < I_SQ) { W = args.in[15] + (size_t)j * DM * DM; N = DM; kind = 4; WT = qkv; }
            else if (r < I_SQ + I_KV) { r -= I_SQ; W = args.in[16] + (size_t)j * DM * 256; N = 256; kind = 5; WT = qkv; }
            else if (r < I_SQ + 2 * I_KV) { r -= I_SQ + I_KV; W = args.in[17] + (size_t)j * DM * 256; N = 256; kind = 6; WT = qkv; }
            else { r -= I_SQ + 2 * I_KV; W = args.in[18] + (size_t)j * DM * DM; N = DM; kind = 0; WT = (bf16*)(ws + WS_WOT) + (size_t)j * DM * DM; } }
        else { r -= 2 * I_CONV + 2 * I_ATT; const int i = r / I_FFN; r -= i * I_FFN;
            bf16* w13 = (bf16*)(ws + WS_W13T) + (size_t)i * 2 * DFF * DM;
            if (r < I_W1) { W = args.in[21] + (size_t)i * DM * DFF; K = DM; N = DFF; kind = 2; WT = w13; }
            else if (r < 2 * I_W1) { r -= I_W1; W = args.in[22] + (size_t)i * DM * DFF; K = DM; N = DFF; kind = 3; WT = w13; }
            else { r -= 2 * I_W1; W = args.in[23] + (size_t)i * DFF * DM; K = DFF; N = DM; kind = 0; WT = (bf16*)(ws + WS_W2T) + (size_t)i * DM * DFF; } }
        const int nblk = N / 32, kb = r / nblk, nb = r % nblk;
        transpose_item(W, N, WT, K, map_row(kind, 32 * nb), scr, 64 * kb, 32 * nb, F.lane);
    }
    __syncthreads();
    if (blockIdx.x == 0) { float* tab = (float*)(ws + WS_ROPE);
        for (int idx = F.tid; idx < 64 * 16; idx += NWAVES * 64) { const int pos = idx >> 4, j = idx & 15; const float fr = powf(10000.0f, -(float)j * (1.0f / 16.0f)); const float ang = (float)pos * fr;
            tab[2 * idx] = cosf(ang); tab[2 * idx + 1] = sinf(ang); } }
    LAS float* sc = (LAS float*)F.lds;
    LAS float* red = sc + 9 * 1024;
    for (int idx = F.tid; idx < 9 * 1024; idx += NWAVES * 64) { const int mr = idx >> 10, k = idx & 1023; const float v = mr < 8 ? args.in[1][mr * DM + k] : args.in[3][k]; sc[idx] = v / (1.0f + __expf(-v)); }
    __syncthreads();
    float* mod = (float*)(ws + WS_MOD);
    for (int item = F.vcu; item < DEPTH * 48; item += F.G) {
        const int i = item / 48, cgp = item % 48;
        const float* W = args.in[4] + (size_t)i * DM * MODW + cgp * 128 + 2 * F.lane;
        float a0[9], a1[9];
#pragma unroll
        for (int mr = 0; mr < 9; ++mr) { a0[mr] = 0.f; a1[mr] = 0.f; }
        const int k0 = F.wave * 128;
#pragma unroll 8
        for (int kk = 0; kk < 128; ++kk) { const f32x2 w = *(const f32x2*)(W + (size_t)(k0 + kk) * MODW);
#pragma unroll
            for (int mr = 0; mr < 9; ++mr) { const float s = sc[mr * 1024 + k0 + kk]; a0[mr] += s * w.x; a1[mr] += s * w.y; } }
#pragma unroll
        for (int mr = 0; mr < 9; ++mr) { red[(F.wave * 9 + mr) * 128 + 2 * F.lane] = a0[mr]; red[(F.wave * 9 + mr) * 128 + 2 * F.lane + 1] = a1[mr]; }
        __syncthreads();
        for (int o = F.tid; o < 9 * 128; o += NWAVES * 64) { const int mr = o >> 7, col = o & 127; float s = 0.f;
#pragma unroll
            for (int w = 0; w < 8; ++w) s += red[(w * 9 + mr) * 128 + col];
            mod[(size_t)(i * 9 + mr) * MODW + cgp * 128 + col] = s + args.in[5][i * MODW + cgp * 128 + col]; }
        __syncthreads();
    }
}
struct RN { const float* xa; const float* xb; float* oa; float* ob; const float* Y; const float* ssq; const float* gate; const float* gpost; const float* gpre; const float* scm; const float* shm; bf16* H; int nrows; };
__device__ __forceinline__ void resnorm_phase(Frame& F, const RN a) {
    const int gw = F.vcu * NWAVES + F.wave, NGW = F.G * NWAVES; const int per = (a.nrows + NGW - 1) / NGW;
    const int r0 = gw * per, r1 = (r0 + per) < a.nrows ? (r0 + per) : a.nrows;
    const bool has_y = a.Y != nullptr, wr_x = a.oa != nullptr, wr_h = a.H != nullptr;
    int cur = -1; f32x4 A[4], Bv[4], Cv[4];
    for (int r = r0; r < r1; ++r) {
        const int mr = r < MX ? (r >> 11) : 8;
        if (mr != cur) { cur = mr;
#pragma unroll
            for (int j = 0; j < 4; ++j) { const int c = 4 * F.lane + 256 * j;
                if (has_y) A[j] = *(const f32x4*)(a.gate + (size_t)mr * MODW + c) * *(const f32x4*)(a.gpost + c);
                if (wr_h) { Bv[j] = *(const f32x4*)(a.gpre + c) * (*(const f32x4*)(a.scm + (size_t)mr * MODW + c) + 1.0f); Cv[j] = *(const f32x4*)(a.shm + (size_t)mr * MODW + c); } } }
        const float* xr = r < MX ? a.xa + (size_t)r * DM : a.xb + (size_t)(r - MX) * DM;
        f32x4 xv[4];
#pragma unroll
        for (int j = 0; j < 4; ++j) xv[j] = *(const f32x4*)(xr + 4 * F.lane + 256 * j);
        if (has_y) {
            f32x4 yv[4];
#pragma unroll
            for (int j = 0; j < 4; ++j) yv[j] = *(const f32x4*)(a.Y + (size_t)r * DM + 4 * F.lane + 256 * j);
            const float ss = wave_sum(F.lane < 16 ? a.ssq[(size_t)r * 16 + F.lane] : 0.f);
            const float inv = __builtin_amdgcn_rsqf(ss * (1.0f / DM) + EPS);
#pragma unroll
            for (int j = 0; j < 4; ++j) xv[j] = xv[j] + A[j] * (yv[j] * inv);
        }
        if (wr_x) { float* xo = r < MX ? a.oa + (size_t)r * DM : a.ob + (size_t)(r - MX) * DM;
#pragma unroll
            for (int j = 0; j < 4; ++j) *(f32x4*)(xo + 4 * F.lane + 256 * j) = xv[j]; }
        if (wr_h) {
            float s2 = 0.f;
#pragma unroll
            for (int j = 0; j < 4; ++j) s2 += (xv[j].x * xv[j].x + xv[j].y * xv[j].y) + (xv[j].z * xv[j].z + xv[j].w * xv[j].w);
            const float inv2 = __builtin_amdgcn_rsqf(wave_sum(s2) * (1.0f / DM) + EPS);
#pragma unroll
            for (int j = 0; j < 4; ++j) { const f32x4 h = xv[j] * inv2 * Bv[j] + Cv[j]; v2u w; w.x = pk2(h.x, h.y); w.y = pk2(h.z, h.w); *(v2u*)(a.H + (size_t)r * DM + 4 * F.lane + 256 * j) = w; }
        }
    }
}
__device__ __forceinline__ float bf_lo(unsigned v) { return __builtin_bit_cast(float, v << 16); }
__device__ __forceinline__ float bf_hi(unsigned v) { return __builtin_bit_cast(float, v & 0xffff0000u); }
__device__ __forceinline__ void conv_phase(Frame& F, const Args& args, int jc, const bf16* U, bf16* CV) {
    const int c0 = 2 * F.tid;
    float w0[31], w1[31];
#pragma unroll
    for (int k = 0; k < 31; ++k) { const f32x2 t = *(const f32x2*)(args.in[9] + (size_t)(jc * 31 + k) * DM + c0); w0[k] = t.x; w1[k] = t.y; }
    const f32x2 bdw = *(const f32x2*)(args.in[10] + jc * DM + c0), lng = *(const f32x2*)(args.in[11] + jc * DM + c0), lnb = *(const f32x2*)(args.in[12] + jc * DM + c0);
    LAS float* red = (LAS float*)F.lds;
    for (int item = F.vcu; item < MT / 8; item += F.G) {
        const int row0 = item * 8; int s0, L; if (row0 < MX) { s0 = row0 & ~(SEQ - 1); L = SEQ; } else { s0 = MX + ((row0 - MX) & ~(CTXL - 1)); L = CTXL; }
        const int t0 = row0 - s0;
        float a0[8], a1[8];
#pragma unroll
        for (int t = 0; t < 8; ++t) { a0[t] = bdw.x; a1[t] = bdw.y; }
#pragma unroll
        for (int r = 0; r < 38; ++r) { const int tt = t0 - 15 + r; float u0 = 0.f, u1 = 0.f;
            if (tt >= 0 && tt < L) { const unsigned v = *(const unsigned*)(U + (size_t)(s0 + tt) * DM + c0); u0 = bf_lo(v); u1 = bf_hi(v); }
#pragma unroll
            for (int t = 0; t < 8; ++t) { const int k = r - t; if (k >= 0 && k <= 30) { a0[t] += w0[k] * u0; a1[t] += w1[k] * u1; } } }
        float st[16];
#pragma unroll
        for (int t = 0; t < 8; ++t) { st[2 * t] = wave_sum(a0[t] + a1[t]); st[2 * t + 1] = wave_sum(a0[t] * a0[t] + a1[t] * a1[t]); }
        if (F.lane == 0) {
#pragma unroll
            for (int i = 0; i < 16; ++i) red[F.wave * 16 + i] = st[i]; }
        __syncthreads();
        if (F.tid < 16) { float s = 0.f;
#pragma unroll
            for (int w = 0; w < 8; ++w) s += red[w * 16 + F.tid];
            red[128 + F.tid] = s; }
        __syncthreads();
#pragma unroll
        for (int t = 0; t < 8; ++t) { const float mu = red[128 + 2 * t] * (1.0f / DM), var = red[128 + 2 * t + 1] * (1.0f / DM) - mu * mu; const float rstd = __builtin_amdgcn_rsqf(fmaxf(var, 0.f) + EPS);
            const float y0 = (a0[t] - mu) * rstd * lng.x + lnb.x, y1 = (a1[t] - mu) * rstd * lng.y + lnb.y;
            *(unsigned*)(CV + (size_t)(row0 + t) * DM + c0) = pk2(y0 / (1.0f + __expf(-y0)), y1 / (1.0f + __expf(-y1))); }
    }
    __syncthreads();
}

__global__ void __launch_bounds__(NWAVES * 64, 2) mk_fwd(Args args) {
    extern __shared__ __attribute__((aligned(16))) unsigned char lds[];

    for (int ph = args.ph_lo; ph < args.ph_hi; ++ph) {
        unsigned char* ws = args.ws; asm volatile("" : "+s"(ws));
        Frame F;
        F.lds = (LAS unsigned char*)lds;
        { int t_ = threadIdx.x; asm volatile("" : "+v"(t_)); F.tid = t_; } F.lane = F.tid & 63; F.wave = __builtin_amdgcn_readfirstlane(F.tid >> 6);
        F.G = gridDim.x; { const int bx = blockIdx.x; F.vcu = (F.G % 8 == 0) ? (bx % 8) * (F.G / 8) + bx / 8 : bx; }
        F.out = args.out; F.ws = ws;
        float* const mod = (float*)(ws + WS_MOD); float* const X = (float*)(ws + WS_X); float* const Y = (float*)(ws + WS_Y); float* const SSQ = (float*)(ws + WS_SSQ);
        bf16* const H = (bf16*)(ws + WS_H); bf16* const U = (bf16*)(ws + WS_U); bf16* const CV = (bf16*)(ws + WS_CV); bf16* const KB = (bf16*)(ws + WS_KB); bf16* const VB = (bf16*)(ws + WS_VB); bf16* const GB = (bf16*)(ws + WS_G);
        const float* const normg = args.in[6];
        if (ph == 0) {
#if !(DIS & 1)
 p0_prologue(F, args);
#endif
 }
        else if (ph == 1) {
            RN a{args.in[0], args.in[2], nullptr, nullptr, nullptr, nullptr, nullptr, nullptr, normg, mod + 1 * DM, mod + 0 * DM, H, MT};
            resnorm_phase(F, a);
        } else {
            const int L = (ph - 2) / 7, sub = (ph - 2) % 7; const bool conv = (L & 1) == 0, last = (L == DEPTH - 1); const int jl = L >> 1;
            const int nMrows = last ? MX / 256 : MT / 256;
            if (sub == 0) {
                if (conv) {
                    pg8::Gemm g{H, (const bf16*)(ws + WS_PW1T) + (size_t)jl * 2 * DM * DM, MT, 2 * DM, DM}; pg8::TileOrder S; S.init(MT / 256, 8, 0, 0, 0, 1, F.G, (int)blockIdx.x);
                    pg8::EpiGate<0> E{U, DM, args.in[8] + jl * 2 * DM};
#if !(DIS & 2)
                    pg8::gemm_phase<pg8::EpiGate<0>, pg8::TileOrder, true, true>(F.lds, g, S, E);
#endif
                } else {
                    pg8::Gemm g{H, (const bf16*)(ws + WS_QKVT) + (size_t)jl * 1536 * DM, MT, 1536, DM}; pg8::TileOrder S;
                    if (last) S.init(MX / 256, 6, 2 * (MC / 256), MX / 256, 4, 2, F.G, (int)blockIdx.x); else S.init(MT / 256, 6, 0, 0, 0, 1, F.G, (int)blockIdx.x);
                    pg8::EpiQKV E{U, KB, VB, args.in[19] + jl * 64, args.in[20] + jl * 64, (const float*)(ws + WS_ROPE)};
#if !(DIS & 4)
                    pg8::gemm_phase<pg8::EpiQKV, pg8::TileOrder, true, true>(F.lds, g, S, E);
#endif
                }
            } else if (sub == 1) {
                if (conv) {
#if !(DIS & 8)
 conv_phase(F, args, jl, U, CV);
#endif
 }
                else {
                    const int nxu = NBATCH * 16 * (SEQ / 256), ncu = last ? 0 : NBATCH * 16;
                    for (int id = F.vcu; id < nxu + ncu; id += F.G) {
                        int b, h, NT, NTX; long qrow, xr0, cr0;
                        if (id < nxu) { b = id >> 7; h = (id >> 3) & 15; qrow = (long)b * SEQ + (id & 7) * 256; NT = 36; NTX = 32; xr0 = (long)b * SEQ; cr0 = MX + (long)b * CTXL; }
                        else { const int e = id - nxu; b = e >> 4; h = e & 15; qrow = MX + (long)b * CTXL; NT = 4; NTX = 0; xr0 = 0; cr0 = MX + (long)b * CTXL; }
#if !(DIS & 16)
                        attn_body::attn_unit<8>((const attn_body::bf16*)U + qrow * DM + h * 64, (const attn_body::bf16*)KB + (h >> 2) * 64, (const attn_body::bf16*)VB + (h >> 2) * 64,
                                                (attn_body::bf16*)U + qrow * DM + h * 64, NT, NTX, xr0, cr0, (char*)lds);
#endif
                    }
                }
            } else if (sub == 2 || sub == 5) {
                pg8::Gemm g; const float* bias = nullptr;
                if (sub == 5) g = pg8::Gemm{GB, (const bf16*)(ws + WS_W2T) + (size_t)L * DM * DFF, MT, DM, DFF};
                else if (conv) { g = pg8::Gemm{CV, (const bf16*)(ws + WS_PW2T) + (size_t)jl * DM * DM, MT, DM, DM}; bias = args.in[14] + jl * DM; }
                else g = pg8::Gemm{U, (const bf16*)(ws + WS_WOT) + (size_t)jl * DM * DM, MT, DM, DM};
                pg8::TileOrder S; S.init(nMrows, 4, 0, 0, 0, 1, F.G, (int)blockIdx.x);
                pg8::EpiY E{Y, SSQ, bias};
#if !(DIS & 32)
                pg8::gemm_phase<pg8::EpiY, pg8::TileOrder, true, true>(F.lds, g, S, E);
#endif
            } else if (sub == 3) {
                const float* ml = mod + (size_t)L * 9 * MODW;
                RN a{L == 0 ? args.in[0] : X, L == 0 ? args.in[2] : X + (size_t)MX * DM, X, X + (size_t)MX * DM, Y, SSQ, ml + 2 * DM, normg + (L * 4 + 1) * DM, normg + (L * 4 + 2) * DM, ml + 4 * DM, ml + 3 * DM, H, nMrows * 256};
                resnorm_phase(F, a);
            } else if (sub == 4) {
                pg8::Gemm g{H, (const bf16*)(ws + WS_W13T) + (size_t)L * 2 * DFF * DM, MT, 2 * DFF, DM}; pg8::TileOrder S; S.init(nMrows, 2 * DFF / 256, 0, 0, 0, 1, F.G, (int)blockIdx.x);
                pg8::EpiGate<1> E{GB, DFF, nullptr};
#if !(DIS & 64)
                pg8::gemm_phase<pg8::EpiGate<1>, pg8::TileOrder, true, true>(F.lds, g, S, E);
#endif
            } else {
                const float* ml = mod + (size_t)L * 9 * MODW; const float* mn = mod + (size_t)(L + 1) * 9 * MODW;
                RN a{X, X + (size_t)MX * DM, last ? F.out : X, X + (size_t)MX * DM, Y, SSQ, ml + 5 * DM, normg + (L * 4 + 3) * DM,
                     last ? nullptr : normg + ((L + 1) * 4 + 0) * DM, last ? nullptr : mn + 1 * DM, last ? nullptr : mn + 0 * DM, last ? nullptr : H, nMrows * 256};
                resnorm_phase(F, a);
            }
        }
        if (ph + 1 < args.ph_hi) cg::this_grid().sync();
    }
}

#ifndef DIS
#define DIS 0
#endif
#ifndef MK_MULTI
#define MK_MULTI 0
#endif
extern "C" void kernel_launch(void* const* d_in, const int* in_sizes, int n_in, void* d_out, int out_size, void* d_ws, size_t ws_size, hipStream_t stream) {
    static int grid = 0;
    if (grid == 0) {
        if (n_in != 24 || out_size != MX * DM || ws_size < WS_END) { fprintf(stderr, "kernel_launch: unexpected shapes: n_in %d out %d ws %zu (need %zu)\n", n_in, out_size, ws_size, (size_t)WS_END); grid = -1; return; }
        int dev = 0, cus = 0, per_cu = 0;
        if (hipGetDevice(&dev) != hipSuccess || hipDeviceGetAttribute(&cus, hipDeviceAttributeMultiprocessorCount, dev) != hipSuccess) { grid = -1; return; }
        if (hipFuncSetAttribute((const void*)mk_fwd, hipFuncAttributeMaxDynamicSharedMemorySize, LDS_BYTES) != hipSuccess) { fprintf(stderr, "kernel_launch: hipFuncSetAttribute failed\n"); grid = -1; return; }
        if (hipOccupancyMaxActiveBlocksPerMultiprocessor(&per_cu, (const void*)mk_fwd, NWAVES * 64, LDS_BYTES) != hipSuccess || per_cu < 1) { fprintf(stderr, "kernel_launch: occupancy query says %d blocks per CU\n", per_cu); per_cu = 1; }
        (void)hipGetLastError();
        grid = cus;
    }
    if (grid < 0) return;
    Args a{};
    for (int i = 0; i < 24; ++i) a.in[i] = (const float*)d_in[i];
    a.out = (float*)d_out; a.ws = (unsigned char*)d_ws;
#if MK_MULTI
    for (int ph = 0; ph < N_PHASES; ++ph) { a.ph_lo = ph; a.ph_hi = ph + 1; hipLaunchKernelGGL(mk_fwd, dim3(grid), dim3(NWAVES * 64), LDS_BYTES, stream, a); }
#else
    a.ph_lo = 0; a.ph_hi = N_PHASES;
    void* kargs[] = {&a};
    hipError_t e = hipLaunchCooperativeKernel((const void*)mk_fwd, dim3(grid), dim3(NWAVES * 64), kargs, LDS_BYTES, stream);
    if (e != hipSuccess) fprintf(stderr, "kernel_launch: cooperative launch failed: %s (grid %d)\n", hipGetErrorString(e), grid);
#endif
}
```

```cpp
#define MK_MULTI 0
#include <hip/hip_runtime.h>
#include <hip/hip_cooperative_groups.h>
#include <cstdio>
#include <cstdint>
namespace pg8 {
#define PG8_LAS __attribute__((address_space(3)))
typedef unsigned short bf16_t;
typedef short bf16x8 __attribute__((ext_vector_type(8)));
typedef float f32x4 __attribute__((ext_vector_type(4)));
typedef unsigned u32x4 __attribute__((ext_vector_type(4)));
constexpr int BM = 256, BK = 64, HALF = 128, HTB = HALF * BK * 2  , STAGE_BYTES = 8 * HTB, NXCD = 8, WGM = 8;

__host__ __device__ __forceinline__ int lds_byte(int r, int c) { const int st = (r >> 4) * 2 + (c >> 5), rr = r & 15, cc = c & 31, ob = rr * 64 + cc * 2; return st * 1024 + (ob ^ (((ob >> 9) & 1) << 5)); }
__host__ __device__ __forceinline__ void stage_rc(int b, int& R, int& C) { const int st = b / 1024, sb = b % 1024, swz = sb ^ (((sb >> 9) & 1) << 5); R = (st >> 1) * 16 + swz / 64; C = (st & 1) * 32 + (swz % 64) / 2; }
__host__ __device__ __forceinline__ int perm32(int rho) { const int n = rho >> 4, i = rho & 15; return 8 * (i >> 2) + 4 * n + (i & 3); }

struct Unit { int pm, pn; };
struct Gemm { const bf16_t* A; const bf16_t* Bt; int M, N, K; };

struct StaticOrder {
    int nM, nN, nwg, G, c;
    __host__ __device__ void init(int M, int N, int G_, int c_) { nM = M / BM; nN = N / BM; nwg = nM * nN; G = G_; c = c_; }
    __host__ __device__ bool next(int i, Unit& u) const {
        const long L = (long)i * G + c; if (L >= nwg) return false;
        int wgid = (int)L; { const int q = nwg / NXCD, r = nwg % NXCD, xcd = wgid % NXCD, off = wgid / NXCD; wgid = (xcd < r ? xcd * (q + 1) : r * (q + 1) + (xcd - r) * q) + off; }
        const int nig = WGM * nN, gid = wgid / nig, fm = gid * WGM, gsz = (nM - fm) < WGM ? (nM - fm) : WGM;
        u.pm = fm + ((wgid % nig) % gsz); u.pn = (wgid % nig) / gsz; return true;
    }
    __device__ __forceinline__ void a_ready(const Unit&) const {}
    __device__ __forceinline__ void done(const Unit&) const {}
};

__device__ __forceinline__ unsigned cvt_pk_bf16(float lo, float hi) { unsigned r; asm volatile("v_cvt_pk_bf16_f32 %0, %1, %2" : "=v"(r) : "v"(lo), "v"(hi)); return r; }
typedef float f32x2 __attribute__((ext_vector_type(2)));
struct TileOrder {
    int nM, nN, nmain, nextra, xpm0, xpn0, xw, G, c;
    __device__ void init(int nM_, int nN_, int nextra_, int xpm0_, int xpn0_, int xw_, int G_, int c_) { nM = nM_; nN = nN_; nmain = nM_ * nN_; nextra = nextra_; xpm0 = xpm0_; xpn0 = xpn0_; xw = xw_; G = G_; c = c_; }
    __device__ bool next(int i, Unit& u) const {
        const long L = (long)i * G + c; if (L >= nmain + nextra) return false;
        if (L >= nmain) { const int e = (int)L - nmain; u.pm = xpm0 + e / xw; u.pn = xpn0 + e % xw; return true; }
        int wgid = (int)L; const int nwg = nmain; { const int q = nwg / NXCD, r = nwg % NXCD, xcd = wgid % NXCD, off = wgid / NXCD; wgid = (xcd < r ? xcd * (q + 1) : r * (q + 1) + (xcd - r) * q) + off; }
        const int nig = WGM * nN, gid = wgid / nig, fm = gid * WGM, gsz = (nM - fm) < WGM ? (nM - fm) : WGM;
        u.pm = fm + ((wgid % nig) % gsz); u.pn = (wgid % nig) / gsz; return true;
    }
    __device__ __forceinline__ void a_ready(const Unit&) const {}
    __device__ __forceinline__ void done(const Unit&) const {}
};
__device__ __forceinline__ float sigmoidf_fast(float x) { return __builtin_amdgcn_rcpf(1.0f + __expf(-x)); }
template <int MODE> struct EpiGate {
    static constexpr bool PERM = true, AFTER_DRAIN = false;
    bf16_t* O; int ldc; const float* bias;
    __device__ __forceinline__ void operator()(const f32x4 (&acc)[2][2][4][2], const Unit& u, int wr, int wc, int fr, int fq) const {
        const int row0 = u.pm * BM + wr * 64 + fr, col0 = u.pn * 128 + wc * 32 + 8 * fq;
        f32x4 ba[2], bb[2];
#pragma unroll
        for (int n = 0; n < 2; ++n) { if (MODE == 0) { ba[n] = *(const f32x4*)(bias + col0 + 4 * n); bb[n] = *(const f32x4*)(bias + 1024 + col0 + 4 * n); } else { ba[n] = (f32x4){0.f, 0.f, 0.f, 0.f}; bb[n] = ba[n]; } }
#pragma unroll
        for (int ai = 0; ai < 2; ++ai)
#pragma unroll
            for (int m = 0; m < 4; ++m) {
                float o[8];
#pragma unroll
                for (int n = 0; n < 2; ++n) { const f32x4 a = acc[ai][0][m][n] + ba[n], b = acc[ai][1][m][n] + bb[n];
#pragma unroll
                    for (int e = 0; e < 4; ++e) o[4 * n + e] = (MODE == 0) ? a[e] * sigmoidf_fast(b[e]) : a[e] * sigmoidf_fast(a[e]) * b[e]; }
                u32x4 w; w.x = cvt_pk_bf16(o[0], o[1]); w.y = cvt_pk_bf16(o[2], o[3]); w.z = cvt_pk_bf16(o[4], o[5]); w.w = cvt_pk_bf16(o[6], o[7]);
                *(u32x4*)(O + (size_t)(row0 + ai * HALF + m * 16) * ldc + col0) = w;
            }
    }
};
struct EpiY {
    static constexpr bool PERM = true, AFTER_DRAIN = false;
    float* Y; float* SSQ; const float* bias;
    __device__ __forceinline__ void operator()(const f32x4 (&acc)[2][2][4][2], const Unit& u, int wr, int wc, int fr, int fq) const {
        const int row0 = u.pm * BM + wr * 64 + fr, col0 = u.pn * BM + wc * 32 + 8 * fq;
        f32x4 bv[2][2];
#pragma unroll
        for (int bj = 0; bj < 2; ++bj)
#pragma unroll
            for (int n = 0; n < 2; ++n) bv[bj][n] = bias ? *(const f32x4*)(bias + col0 + bj * HALF + 4 * n) : (f32x4){0.f, 0.f, 0.f, 0.f};
#pragma unroll
        for (int ai = 0; ai < 2; ++ai)
#pragma unroll
            for (int m = 0; m < 4; ++m) { const int row = row0 + ai * HALF + m * 16; float* yp = Y + (size_t)row * 1024 + col0; float ss = 0.f;
#pragma unroll
                for (int bj = 0; bj < 2; ++bj)
#pragma unroll
                    for (int n = 0; n < 2; ++n) { const f32x4 v = acc[ai][bj][m][n] + bv[bj][n]; *(f32x4*)(yp + bj * HALF + 4 * n) = v; ss += (v[0] * v[0] + v[1] * v[1]) + (v[2] * v[2] + v[3] * v[3]); }
                ss += __shfl_xor(ss, 16); ss += __shfl_xor(ss, 32);
                if (fq == 0) SSQ[(size_t)row * 16 + u.pn * 4 + wc] = ss; }
    }
};
struct EpiQKV {
    static constexpr bool PERM = true, AFTER_DRAIN = false;
    bf16_t *Q, *Kb, *Vb; const float *qg, *kg; const float* rope;
    __device__ __forceinline__ void operator()(const f32x4 (&acc)[2][2][4][2], const Unit& u, int wr, int wc, int fr, int fq) const {
        const int pn = u.pn, row0 = u.pm * BM + wr * 64 + fr; const bool isx = u.pm < 64;
        if (pn == 5) {
#pragma unroll
            for (int ai = 0; ai < 2; ++ai)
#pragma unroll
                for (int m = 0; m < 4; ++m) { bf16_t* dst = Vb + (size_t)(row0 + ai * HALF + m * 16) * 256 + wc * 64 + 8 * fq;
#pragma unroll
                    for (int bj = 0; bj < 2; ++bj) { const f32x4 a = acc[ai][bj][m][0], b = acc[ai][bj][m][1]; u32x4 w; w.x = cvt_pk_bf16(a[0], a[1]); w.y = cvt_pk_bf16(a[2], a[3]); w.z = cvt_pk_bf16(b[0], b[1]); w.w = cvt_pk_bf16(b[2], b[3]);
                        *(u32x4*)(dst + 32 * bj) = w; } }
            return;
        }
        const bool isq = pn < 4; const float* gp = (isq ? qg : kg) + 8 * fq; const float osc = isq ? 0.125f * 1.4426950408889634f : 1.0f;
        f32x4 gv[2][2];
#pragma unroll
        for (int bj = 0; bj < 2; ++bj)
#pragma unroll
            for (int n = 0; n < 2; ++n) gv[bj][n] = *(const f32x4*)(gp + 32 * bj + 4 * n) * osc;
#pragma unroll
        for (int ai = 0; ai < 2; ++ai) {
            f32x4 cs0[2] = {(f32x4){1.f, 0.f, 1.f, 0.f}, (f32x4){1.f, 0.f, 1.f, 0.f}};
            if (isx) { const int posr = 4 * (u.pm & 7) + 2 * ai + wr; const float* rp = rope + (size_t)(posr * 16 + 4 * fq) * 2; cs0[0] = *(const f32x4*)rp; cs0[1] = *(const f32x4*)(rp + 4); }
#pragma unroll
            for (int m = 0; m < 4; ++m) {
                const int row = row0 + ai * HALF + m * 16;
                float ss = 0.f;
#pragma unroll
                for (int bj = 0; bj < 2; ++bj)
#pragma unroll
                    for (int n = 0; n < 2; ++n) { const f32x4 v = acc[ai][bj][m][n]; ss += (v[0] * v[0] + v[1] * v[1]) + (v[2] * v[2] + v[3] * v[3]); }
                ss += __shfl_xor(ss, 16); ss += __shfl_xor(ss, 32);
                const float inv = __builtin_amdgcn_rsqf(ss * (1.0f / 64.0f) + 1e-6f);
                f32x4 cs1[2] = {(f32x4){1.f, 0.f, 1.f, 0.f}, (f32x4){1.f, 0.f, 1.f, 0.f}};
                if (isx) { const int posc = 16 * m + fr; const float* rp = rope + (size_t)(posc * 16 + 4 * fq) * 2; cs1[0] = *(const f32x4*)rp; cs1[1] = *(const f32x4*)(rp + 4); }
                bf16_t* dst = isq ? (Q + (size_t)row * 1024 + (4 * pn + wc) * 64 + 8 * fq) : (Kb + (size_t)row * 256 + wc * 64 + 8 * fq);
#pragma unroll
                for (int bj = 0; bj < 2; ++bj) { float o[8];
#pragma unroll
                    for (int n = 0; n < 2; ++n) { const f32x4 v = acc[ai][bj][m][n] * inv * gv[bj][n]; const f32x4 cs = bj == 0 ? cs0[n] : cs1[n];
                        o[4 * n + 0] = v[0] * cs[0] - v[1] * cs[1]; o[4 * n + 1] = v[0] * cs[1] + v[1] * cs[0];
                        o[4 * n + 2] = v[2] * cs[2] - v[3] * cs[3]; o[4 * n + 3] = v[2] * cs[3] + v[3] * cs[2]; }
                    u32x4 w; w.x = cvt_pk_bf16(o[0], o[1]); w.y = cvt_pk_bf16(o[2], o[3]); w.z = cvt_pk_bf16(o[4], o[5]); w.w = cvt_pk_bf16(o[6], o[7]);
                    *(u32x4*)(dst + 32 * bj) = w; }
            }
        }
    }
};

template <class Epi, class Sched, bool ALIGN_EPI = false, bool SP2 = false>
__device__ __forceinline__ void gemm_phase(PG8_LAS unsigned char* lds, const Gemm g, const Sched& S, const Epi& E) {
    int tid_ = threadIdx.x; asm volatile("" : "+v"(tid_)); const int tid = tid_, wid = __builtin_amdgcn_readfirstlane(tid >> 6), lane = tid & 63, wr = wid >> 2, wc = wid & 3, fr = lane & 15, fq = lane >> 4;
    const int K = g.K, nt = K / BK;
    unsigned voffA[2], voffB[2];
#pragma unroll
    for (int i = 0; i < 2; ++i) { int R, C; stage_rc(tid * 16 + i * 8192, R, C); const int Rb = Epi::PERM ? ((R & ~31) + perm32(R & 31)) : R;
        voffA[i] = (unsigned)(R * K + C) * 2u; voffB[i] = (unsigned)(Rb * K + C) * 2u; }
    const size_t kstep = (size_t)(BK * 2);
    const size_t hstep = (size_t)HALF * K * 2;
    const size_t tstep = 2 * hstep;
    const unsigned ldsw = (unsigned)wid * 1024u;
    const int aoff = lds_byte(wr * 64 + fr, fq * 8), boff = lds_byte(wc * 32 + fr, fq * 8);
#define PG8_SA(b, h) (((b) * 2 + (h)) * HTB)
#define PG8_SB(b, h) ((4 + (b) * 2 + (h)) * HTB)
#define PG8_STAGE(bufoff, gbase, voff) do { _Pragma("unroll") for (int _i = 0; _i < 2; ++_i) \
        __builtin_amdgcn_global_load_lds((const unsigned*)((const char*)(gbase) + (voff)[_i]), (PG8_LAS unsigned*)(lds + (bufoff) + ldsw + _i * 8192), 16, 0, 0); } while (0)
#define PG8_LDA(dst, b, h) do { _Pragma("unroll") for (int m = 0; m < 4; ++m) _Pragma("unroll") for (int k = 0; k < 2; ++k) dst[m][k] = *(const PG8_LAS bf16x8*)(lds + PG8_SA(b, h) + aoff + m * 2048 + k * 1024); } while (0)
#define PG8_LDB(dst, b, h) do { _Pragma("unroll") for (int n = 0; n < 2; ++n) _Pragma("unroll") for (int k = 0; k < 2; ++k) dst[n][k] = *(const PG8_LAS bf16x8*)(lds + PG8_SB(b, h) + boff + n * 2048 + k * 1024); } while (0)
#define PG8_MMA(ai, bj, At, Bt) do { __builtin_amdgcn_s_setprio(1); _Pragma("unroll") for (int m = 0; m < 4; ++m) _Pragma("unroll") for (int n = 0; n < 2; ++n) _Pragma("unroll") for (int k = 0; k < 2; ++k) \
        acc[ai][bj][m][n] = __builtin_amdgcn_mfma_f32_16x16x32_bf16(Bt[n][k], At[m][k], acc[ai][bj][m][n], 0, 0, 0); __builtin_amdgcn_s_setprio(0); } while (0)
#define PG8_WAIT_V(n) asm volatile("s_waitcnt vmcnt(" #n ")" ::: "memory")
#define PG8_WAIT_L(n) asm volatile("s_waitcnt lgkmcnt(" #n ")" ::: "memory")
#define PG8_BAR __builtin_amdgcn_s_barrier()
#define PG8_SCHED __builtin_amdgcn_sched_barrier(0)
    Unit cur, nxt; int ui = 0;
    if (!S.next(0, cur)) return;
    f32x4 acc[2][2][4][2];
#pragma unroll
    for (int a = 0; a < 2; ++a)
#pragma unroll
        for (int b = 0; b < 2; ++b)
#pragma unroll
            for (int m = 0; m < 4; ++m)
#pragma unroll
                for (int n = 0; n < 2; ++n) acc[a][b][m][n] = (f32x4){0.f, 0.f, 0.f, 0.f};
    bf16x8 At[4][2], B0[2][2], B1[2][2];
    const char* cA = (const char*)g.A + (size_t)cur.pm * tstep; const char* cB = (const char*)g.Bt + (size_t)cur.pn * tstep;
    S.a_ready(cur);
    if constexpr (SP2) {
        PG8_STAGE(PG8_SB(0, 0), cB, voffB); PG8_STAGE(PG8_SB(0, 1), cB + hstep, voffB); PG8_STAGE(PG8_SA(0, 0), cA, voffA); PG8_STAGE(PG8_SA(0, 1), cA + hstep, voffA);
        if (wr == 1) PG8_BAR;
        PG8_WAIT_V(2); PG8_BAR;
        PG8_STAGE(PG8_SB(1, 0), cB + kstep, voffB); PG8_STAGE(PG8_SA(1, 0), cA + kstep, voffA); PG8_STAGE(PG8_SB(1, 1), cB + hstep + kstep, voffB);
        PG8_WAIT_V(6); PG8_BAR;
    } else {
        PG8_STAGE(PG8_SB(0, 0), cB, voffB); PG8_STAGE(PG8_SA(0, 0), cA, voffA); PG8_STAGE(PG8_SB(0, 1), cB + hstep, voffB); PG8_STAGE(PG8_SA(0, 1), cA + hstep, voffA);
        if (wr == 1) PG8_BAR;
        PG8_WAIT_V(4); PG8_BAR;
        PG8_STAGE(PG8_SB(1, 0), cB + kstep, voffB); PG8_STAGE(PG8_SA(1, 0), cA + kstep, voffA); PG8_STAGE(PG8_SB(1, 1), cB + hstep + kstep, voffB);
        PG8_WAIT_V(6); PG8_BAR;
    }
    for (;;) {
        const bool has_next = S.next(ui + 1, nxt);
        const char* nA = has_next ? (const char*)g.A + (size_t)nxt.pm * tstep : cA; const char* nB = has_next ? (const char*)g.Bt + (size_t)nxt.pn * tstep : cB;
        for (int t = 0; t < nt; t += 2) {
            const bool last = (t == nt - 2);
            const char* a1 = cA + (size_t)(t + 1) * kstep;
            const char* a2 = last ? nA : cA + (size_t)(t + 2) * kstep; const char* b2 = last ? nB : cB + (size_t)(t + 2) * kstep;
            const char* a3 = a2 + kstep; const char* b3 = b2 + kstep;
            if (last && has_next) S.a_ready(nxt);
            if constexpr (SP2) {
            PG8_LDB(B0, 0, 0); PG8_LDB(B1, 0, 1); PG8_SCHED; PG8_LDA(At, 0, 0); PG8_STAGE(PG8_SA(1, 1), a1 + hstep, voffA);
            PG8_WAIT_V(8); PG8_WAIT_L(0); PG8_BAR; PG8_MMA(0, 0, At, B0); PG8_MMA(0, 1, At, B1); PG8_BAR; PG8_SCHED;
            PG8_LDA(At, 0, 1); PG8_STAGE(PG8_SB(0, 0), b2, voffB); PG8_STAGE(PG8_SB(0, 1), b2 + hstep, voffB); PG8_STAGE(PG8_SA(0, 0), a2, voffA);
            PG8_WAIT_V(8); PG8_WAIT_L(0); PG8_BAR; PG8_MMA(1, 0, At, B0); PG8_MMA(1, 1, At, B1); PG8_BAR; PG8_SCHED;
            PG8_LDB(B0, 1, 0); PG8_LDB(B1, 1, 1); PG8_SCHED; PG8_LDA(At, 1, 0); PG8_STAGE(PG8_SA(0, 1), a2 + hstep, voffA);
            PG8_WAIT_V(8); PG8_WAIT_L(0); PG8_BAR; PG8_MMA(0, 0, At, B0); PG8_MMA(0, 1, At, B1); PG8_BAR; PG8_SCHED;
            PG8_LDA(At, 1, 1); PG8_STAGE(PG8_SB(1, 0), b3, voffB); PG8_STAGE(PG8_SB(1, 1), b3 + hstep, voffB); PG8_STAGE(PG8_SA(1, 0), a3, voffA);
            PG8_WAIT_V(8); PG8_WAIT_L(0); PG8_BAR; PG8_MMA(1, 0, At, B0); PG8_MMA(1, 1, At, B1); PG8_BAR; PG8_SCHED;
            } else {
            PG8_LDB(B0, 0, 0); PG8_SCHED; PG8_LDA(At, 0, 0); PG8_STAGE(PG8_SA(1, 1), a1 + hstep, voffA);
            PG8_WAIT_L(8); PG8_BAR; PG8_WAIT_L(0); PG8_MMA(0, 0, At, B0); PG8_BAR; PG8_SCHED;
            PG8_LDB(B1, 0, 1); PG8_STAGE(PG8_SB(0, 0), b2, voffB);
            PG8_BAR; PG8_WAIT_L(0); PG8_MMA(0, 1, At, B1); PG8_BAR;
            PG8_LDA(At, 0, 1); PG8_STAGE(PG8_SA(0, 0), a2, voffA);
            PG8_BAR; PG8_WAIT_L(0); PG8_MMA(1, 0, At, B0); PG8_BAR; PG8_SCHED;
            PG8_STAGE(PG8_SB(0, 1), b2 + hstep, voffB);
            PG8_WAIT_V(6); PG8_BAR; PG8_MMA(1, 1, At, B1); PG8_BAR;
            PG8_LDB(B0, 1, 0); PG8_SCHED; PG8_LDA(At, 1, 0); PG8_STAGE(PG8_SA(0, 1), a2 + hstep, voffA);
            PG8_WAIT_L(8); PG8_BAR; PG8_WAIT_L(0); PG8_MMA(0, 0, At, B0); PG8_BAR; PG8_SCHED;
            PG8_LDB(B1, 1, 1); PG8_STAGE(PG8_SB(1, 0), b3, voffB);
            PG8_BAR; PG8_WAIT_L(0); PG8_MMA(0, 1, At, B1); PG8_BAR;
            PG8_LDA(At, 1, 1); PG8_STAGE(PG8_SA(1, 0), a3, voffA);
            PG8_BAR; PG8_WAIT_L(0); PG8_MMA(1, 0, At, B0); PG8_BAR; PG8_SCHED;
            PG8_STAGE(PG8_SB(1, 1), b3 + hstep, voffB);
            PG8_WAIT_V(6); PG8_BAR; PG8_MMA(1, 1, At, B1); PG8_BAR;
            }
        }
        if constexpr (ALIGN_EPI) { if (wr == 0) PG8_BAR; }
        if constexpr (!Epi::AFTER_DRAIN) { E(acc, cur, wr, wc, fr, fq); S.done(cur); }
        if (!has_next) break;
#pragma unroll
        for (int a = 0; a < 2; ++a)
#pragma unroll
            for (int b = 0; b < 2; ++b)
#pragma unroll
                for (int m = 0; m < 4; ++m)
#pragma unroll
                    for (int n = 0; n < 2; ++n) acc[a][b][m][n] = (f32x4){0.f, 0.f, 0.f, 0.f};
        cur = nxt; cA = nA; cB = nB; ++ui;
        if constexpr (ALIGN_EPI) { if (wr == 1) PG8_BAR; }
    }
    PG8_WAIT_V(0);
    if constexpr (!ALIGN_EPI) { if (wr == 0) PG8_BAR; }
    PG8_BAR;
    if constexpr (Epi::AFTER_DRAIN) { E.fused(acc, cur, wr, wc, fr, fq, lds, wid, lane); S.done(cur); }
#undef PG8_SA
#undef PG8_SB
#undef PG8_STAGE
#undef PG8_LDA
#undef PG8_LDB
#undef PG8_MMA
#undef PG8_WAIT_V
#undef PG8_WAIT_L
#undef PG8_BAR
#undef PG8_SCHED
}
}
#include <hip/hip_bf16.h>
#include <cmath>
namespace attn_body {
using bf16=__hip_bfloat16;
using bf16x8=__attribute__((ext_vector_type(8)))short;
using s16x4=__attribute__((ext_vector_type(4)))short;
using f32x16=__attribute__((ext_vector_type(16)))float;
using u32x4=__attribute__((ext_vector_type(4)))unsigned;
constexpr int D=64,DM=1024,KVP=256;
constexpr int NW=8,QBLK=32,QB=QBLK*NW,KVBLK=64;
constexpr int ATTN_PITCH=DM, ATTN_UNIT_ROWS=QB;
__device__ __forceinline__ int crow(int r,int hi){return (r&3)+8*(r>>2)+4*hi;}
#define SBAR() __builtin_amdgcn_sched_barrier(0)
__device__ __forceinline__ void cmask(f32x16&p0,f32x16&p1,int jb,int qrel,int hi){
  const float NEG=-INFINITY; int kb=64*jb+4*hi;
  #pragma unroll
  for(int r=0;r<16;++r){int kv=kb+(r&3)+8*(r>>2); if(kv>qrel)p0[r]=NEG; if(kv+32>qrel)p1[r]=NEG;}
}

constexpr int NSLOT=3, SLOTB=8192;
constexpr int LDS_K=0, LDS_V=NSLOT*SLOTB, LDS_WS=2*NSLOT*SLOTB, LDS_OST=LDS_WS+NW*64*4, LDS_BYTES=LDS_OST+NW*4096;
constexpr float C2=0.125f*1.4426950408889634f;
__device__ __forceinline__ void glds16(const void*gsrc,unsigned lds_dst){unsigned keep;
  asm volatile("s_mov_b32 %0, m0\n\ts_mov_b32 m0, %2\n\ts_nop 0\n\tglobal_load_lds_dwordx4 %1, off\n\ts_mov_b32 m0, %0":"=&s"(keep):"v"(gsrc),"s"(lds_dst):"memory");}
__device__ __forceinline__ float max3f(float a,float b,float c){float r;asm("v_max3_f32 %0, %1, %2, %3":"=v"(r):"v"(a),"v"(b),"v"(c));return r;}
__device__ __forceinline__ float max2f(float a,float b){float r;asm("v_max_f32_e32 %0, %1, %2":"=v"(r):"v"(a),"v"(b));return r;}
__device__ __forceinline__ float fadd_s(float a,float b){float r;asm("v_add_f32_e32 %0, %1, %2":"=v"(r):"v"(a),"v"(b));return r;}
__device__ __forceinline__ float fsub_s(float a,float b){float r;asm("v_sub_f32_e32 %0, %1, %2":"=v"(r):"v"(a),"v"(b));return r;}
typedef float f32x2_t __attribute__((ext_vector_type(2))); typedef __bf16 bf16x2_t __attribute__((ext_vector_type(2)));
__device__ __forceinline__ unsigned cvtpk_s(float lo,float hi){f32x2_t v={lo,hi};bf16x2_t b=__builtin_convertvector(v,bf16x2_t);return __builtin_bit_cast(unsigned,b);}
#define WAIT_BAR(N) asm volatile("s_waitcnt vmcnt(" #N ") lgkmcnt(0)\n\ts_barrier":::"memory")

__device__ __forceinline__ void qkt(f32x16&p0,f32x16&p1,const char*Kslot,const bf16x8*qr,const f32x16&negm,int r32,int hi){
  const char*kb=Kslot+hi*1024+r32*16;
  #pragma unroll
  for(int d0=0;d0<4;++d0){
    const bf16x8 b0=*reinterpret_cast<const bf16x8*>(kb+d0*2048);
    const bf16x8 b1=*reinterpret_cast<const bf16x8*>(kb+d0*2048+512);
    if(d0==0){p0=__builtin_amdgcn_mfma_f32_32x32x16_bf16(b0,qr[0],negm,0,0,0);p1=__builtin_amdgcn_mfma_f32_32x32x16_bf16(b1,qr[0],negm,0,0,0);}
    else{p0=__builtin_amdgcn_mfma_f32_32x32x16_bf16(b0,qr[d0],p0,0,0,0);p1=__builtin_amdgcn_mfma_f32_32x32x16_bf16(b1,qr[d0],p1,0,0,0);}}
}
typedef __attribute__((address_space(3))) const char* lds_cptr;
typedef short v4i16_t __attribute__((ext_vector_type(4)));
__device__ __forceinline__ void kload8(bf16x8*kf,lds_cptr kp){
  kf[0]=*(const __attribute__((address_space(3))) bf16x8*)(kp);      kf[1]=*(const __attribute__((address_space(3))) bf16x8*)(kp+512);
  kf[2]=*(const __attribute__((address_space(3))) bf16x8*)(kp+2048); kf[3]=*(const __attribute__((address_space(3))) bf16x8*)(kp+2560);
  kf[4]=*(const __attribute__((address_space(3))) bf16x8*)(kp+4096); kf[5]=*(const __attribute__((address_space(3))) bf16x8*)(kp+4608);
  kf[6]=*(const __attribute__((address_space(3))) bf16x8*)(kp+6144); kf[7]=*(const __attribute__((address_space(3))) bf16x8*)(kp+6656);
}
__device__ __forceinline__ void kload2(bf16x8*kf,lds_cptr kp,int j){ kf[2*j]=*(const __attribute__((address_space(3))) bf16x8*)(kp+j*2048); kf[2*j+1]=*(const __attribute__((address_space(3))) bf16x8*)(kp+j*2048+512); }
__device__ __forceinline__ s16x4 vtr(lds_cptr p){ return __builtin_bit_cast(s16x4,__builtin_amdgcn_ds_read_tr16_b64_v4i16((__attribute__((address_space(3))) v4i16_t*)p)); }
__device__ __forceinline__ float rowmax(const f32x16&p0,const f32x16&p1){
  float a=max3f(p0[0],p0[1],p1[0]),b=max3f(p0[2],p0[3],p1[1]);a=max3f(a,p1[2],p1[3]);
  #pragma unroll
  for(int r=4;r<16;r+=4){a=max3f(a,p0[r],p0[r+1]);b=max3f(b,p0[r+2],p0[r+3]);a=max3f(a,p1[r],p1[r+1]);b=max3f(b,p1[r+2],p1[r+3]);}
  const float m=max2f(a,b);
  auto rr=__builtin_amdgcn_permlane32_swap(__float_as_uint(m),__float_as_uint(m),false,false);
  return max2f(__uint_as_float(rr[0]),__uint_as_float(rr[1]));
}
__device__ __forceinline__ void pv(f32x16*o,int vb,bf16x8 pa0,bf16x8 pa1,bf16x8 pa2,bf16x8 pa3){
  #pragma unroll
  for(int d0=0;d0<2;++d0){s16x4 lo[4],hi[4];
    #pragma unroll
    for(int ks=0;ks<4;++ks){
      asm volatile("ds_read_b64_tr_b16 %0,%1 offset:%c2":"=&v"(lo[ks]):"v"(vb),"i"(d0*4096+ks*1024):"memory");
      asm volatile("ds_read_b64_tr_b16 %0,%1 offset:%c2":"=&v"(hi[ks]):"v"(vb),"i"(d0*4096+ks*1024+512):"memory");}
    asm volatile("s_waitcnt lgkmcnt(0)":::"memory");SBAR();
    #define PK(k) (bf16x8){lo[k][0],lo[k][1],lo[k][2],lo[k][3],hi[k][0],hi[k][1],hi[k][2],hi[k][3]}
    o[d0]=__builtin_amdgcn_mfma_f32_32x32x16_bf16(pa0,PK(0),o[d0],0,0,0);
    o[d0]=__builtin_amdgcn_mfma_f32_32x32x16_bf16(pa1,PK(1),o[d0],0,0,0);
    o[d0]=__builtin_amdgcn_mfma_f32_32x32x16_bf16(pa2,PK(2),o[d0],0,0,0);
    o[d0]=__builtin_amdgcn_mfma_f32_32x32x16_bf16(pa3,PK(3),o[d0],0,0,0);
    #undef PK
  }
}

#ifndef ATTN_STORE16
#define ATTN_STORE16(p,v) (*(u32x4*)(p)=(v))
#endif
template<int THRL> __device__ __forceinline__ void attn_unit(const bf16*Qb,const bf16*__restrict__ Kh,const bf16*__restrict__ Vh,bf16*Ob,const int NT,const int NTX,const long xr0,const long cr0,char*shm){
  int tid_=threadIdx.x; asm volatile("":"+v"(tid_)); const int tid=tid_,lane=tid&63,r32=lane&31,hi=lane>>5; const int wid=__builtin_amdgcn_readfirstlane(tid>>6);
  const bf16*Qw=Qb+(long)(wid*QBLK)*DM;
  const unsigned lds0=(unsigned)(uintptr_t)shm;
  float*wsf=(float*)(shm+LDS_WS)+wid*64;
  const bf16*ksrc=Kh+(long)lane*KVP+wid*8;
  const bf16*vsrc=Vh+(long)(16*(wid&3)+(lane>>2))*KVP+(wid>>2)*32+(lane&3)*8;
  const unsigned kdst=lds0+LDS_K+wid*1024, vdst=lds0+LDS_V+wid*1024;
  #define KVROW(t) (((t)<NTX)?(xr0+(long)(t)*KVBLK):(cr0+(long)((t)-NTX)*KVBLK))
  #define DMA_K(t,slot) glds16(ksrc+KVROW(t)*KVP,(unsigned)__builtin_amdgcn_readfirstlane(kdst+(slot)))
  #define DMA_V(t,slot) glds16(vsrc+KVROW(t)*KVP,(unsigned)__builtin_amdgcn_readfirstlane(vdst+(slot)))
  const int vb0=(int)(lds0+LDS_V)+((lane>>4)&1)*32+(lane&3)*8+(4*hi+((lane&15)>>2))*64;
  const char*Kbase=shm+LDS_K; bf16x8 kf[8];
  const lds_cptr shm3=(lds_cptr)shm; const lds_cptr kp0=shm3+LDS_K+hi*1024+r32*16; const lds_cptr vp0=shm3+LDS_V+((lane>>4)&1)*32+(lane&3)*8+(4*hi+((lane&15)>>2))*64;
  DMA_K(0,0);DMA_V(0,0);DMA_K(1,SLOTB);
  bf16x8 qr[4];
  #pragma unroll
  for(int d0=0;d0<4;++d0)qr[d0]=*reinterpret_cast<const bf16x8*>(&Qw[(long)r32*DM+d0*16+hi*8]);
  float mhat=0.f,l_reg=0.f;f32x16 o[2];o[0]=f32x16{};o[1]=f32x16{};f32x16 negm=f32x16{};asm volatile("":"+v"(negm));
  #define CMASK(P0,P1,t) do{}while(0)
  bool resc=false;
  #define START(P0,P1) do{ const float rm=rowmax(P0,P1); resc=false; \
    { const float dl=rm; mhat=fadd_s(mhat,dl); \
      _Pragma("unroll") for(int r=0;r<16;++r){P0[r]=fsub_s(P0[r],dl);P1[r]=fsub_s(P1[r],dl);} \
      _Pragma("unroll") for(int r=0;r<16;++r)negm[r]=-mhat; asm volatile("":"+v"(negm)); } \
    _Pragma("unroll") for(int r=0;r<16;++r)P0[r]=__builtin_amdgcn_exp2f(P0[r]); }while(0)
  #define RESC() do{ if(resc){ asm volatile("s_waitcnt lgkmcnt(0)":::"memory"); \
      _Pragma("unroll") for(int d_=0;d_<2;++d_) _Pragma("unroll") for(int r=0;r<16;++r)o[d_][r]*=wsf[crow(r,hi)]; } }while(0)
  f32x16 pA0,pA1,pB0,pB1;
  int sl_prev=0,sl_cur=0,sl_next=SLOTB;
  #define ROT() do{sl_prev=sl_cur;sl_cur=sl_next;sl_next=(sl_next==(NSLOT-1)*SLOTB)?0:sl_next+SLOTB;}while(0)
  DMA_K(2,2*SLOTB);
  WAIT_BAR(3);
  qkt(pA0,pA1,Kbase,qr,negm,r32,hi);asm volatile("s_nop 15\n\ts_nop 7":"+v"(pA0),"+v"(pA1));CMASK(pA0,pA1,0);
  START(pA0,pA1);
  _Pragma("unroll") for(int r=0;r<16;++r)pA1[r]=__builtin_amdgcn_exp2f(pA1[r]);
  WAIT_BAR(0);
  DMA_K(3,0);DMA_V(1,SLOTB);
  ROT();
  kload8(kf,kp0+sl_cur);
  WAIT_BAR(2);
  s16x4 vlo[8],vhi[8]; u32x4 pw0,pw1,pw2,pw3;
  #define PKW(P,B) cvtpk_s(P[B],P[B+1])
  #define PAF(k) __builtin_bit_cast(bf16x8,pw##k)
  #define VFR(i) (bf16x8){vlo[i][0],vlo[i][1],vlo[i][2],vlo[i][3],vhi[i][0],vhi[i][1],vhi[i][2],vhi[i][3]}
  #define PIN(x) asm volatile("":"+v"(x))
  #define MX3(a,b,c) __builtin_fmaxf(__builtin_fmaxf((a),(b)),(c))
  #define GAPA(MF,A0,A1,A2,A3,W0,W1,PW) do{ MF; sacc+=A0; sacc+=A1; sacc+=A2; sacc+=A3; PIN(sacc); W0; W1; PIN(PW); SBAR(); }while(0)
  #define EX(v) __builtin_amdgcn_exp2f(v)
  #define GAPB(MF,X,B) do{ MF; X[B]=EX(X[B]); X[B+1]=EX(X[B+1]); X[B+2]=EX(X[B+2]); X[B+3]=EX(X[B+3]); PIN(X); SBAR(); }while(0)
  #define VRD(i) do{ vlo[i]=vtr(vp_+(((i)>>2)*4096+((i)&3)*1024)); vhi[i]=vtr(vp_+(((i)>>2)*4096+((i)&3)*1024+512)); }while(0)
  #define KRD(G,j) do{ if(G){ kload2(kf,kp0+sl_next,j); SBAR(); } }while(0)
  #define STEP(C0,C1,P0,P1,t,GK,GV,GL) do{ SBAR(); \
    const lds_cptr vp_=vp0+sl_prev; \
    VRD(0); SBAR(); float sacc=(P0[0]+P0[1]); \
    GAPA(C0=__builtin_amdgcn_mfma_f32_32x32x16_bf16(kf[0],qr[0],negm,0,0,0), P0[2],P0[3],P0[4],P0[5],     pw0[0]=PKW(P0,0), pw0[1]=PKW(P0,2), pw0); \
    VRD(4); SBAR(); GAPA(C1=__builtin_amdgcn_mfma_f32_32x32x16_bf16(kf[1],qr[0],negm,0,0,0), P0[6],P0[7],P0[8],P0[9],     pw0[2]=PKW(P0,4), pw0[3]=PKW(P0,6), pw0); \
    VRD(1); SBAR(); GAPA(C0=__builtin_amdgcn_mfma_f32_32x32x16_bf16(kf[2],qr[1],C0,0,0,0),   P0[10],P0[11],P0[12],P0[13], pw1[0]=PKW(P0,8), pw1[1]=PKW(P0,10), pw1); \
    VRD(5); SBAR(); GAPA(C1=__builtin_amdgcn_mfma_f32_32x32x16_bf16(kf[3],qr[1],C1,0,0,0),   P0[14],P0[15],P1[0],P1[1],   pw1[2]=PKW(P0,12),pw1[3]=PKW(P0,14), pw1); \
    VRD(2); SBAR(); GAPA(C0=__builtin_amdgcn_mfma_f32_32x32x16_bf16(kf[4],qr[2],C0,0,0,0),   P1[2],P1[3],P1[4],P1[5],     pw2[0]=PKW(P1,0), pw2[1]=PKW(P1,2), pw2); \
    VRD(6); SBAR(); GAPA(C1=__builtin_amdgcn_mfma_f32_32x32x16_bf16(kf[5],qr[2],C1,0,0,0),   P1[6],P1[7],P1[8],P1[9],     pw2[2]=PKW(P1,4), pw2[3]=PKW(P1,6), pw2); \
    VRD(3); SBAR(); GAPA(C0=__builtin_amdgcn_mfma_f32_32x32x16_bf16(kf[6],qr[3],C0,0,0,0),   P1[10],P1[11],P1[12],P1[13], pw3[0]=PKW(P1,8), pw3[1]=PKW(P1,10), pw3); \
    VRD(7); SBAR(); GAPA(C1=__builtin_amdgcn_mfma_f32_32x32x16_bf16(kf[7],qr[3],C1,0,0,0),   P1[14],P1[15],0.f,0.f,       pw3[2]=PKW(P1,12),pw3[3]=PKW(P1,14), pw3); \
    l_reg+=sacc; \
    if(GK){DMA_K((t)+3,sl_cur);} if(GV){DMA_V((t)+1,sl_next);} \
    CMASK(C0,C1,t); \
    { float a=MX3(C0[0],C0[1],C1[0]),b=MX3(C0[2],C0[3],C1[1]); a=MX3(a,C1[2],C1[3]); \
      _Pragma("unroll") for(int r=4;r<16;r+=4){a=MX3(a,C0[r],C0[r+1]);b=MX3(b,C0[r+2],C0[r+3]);a=MX3(a,C1[r],C1[r+1]);b=MX3(b,C1[r+2],C1[r+3]);} \
      float rm=__builtin_fmaxf(a,b); { auto rr=__builtin_amdgcn_permlane32_swap(__float_as_uint(rm),__float_as_uint(rm),false,false); rm=__builtin_fmaxf(__uint_as_float(rr[0]),__uint_as_float(rr[1])); } \
      resc=false; \
      if(__builtin_expect(__any(rm>(float)THRL),0)){ const float dl=__builtin_fmaxf(rm,0.f); mhat+=dl; \
        _Pragma("unroll") for(int r=0;r<16;++r){C0[r]-=dl;C1[r]-=dl;} \
        _Pragma("unroll") for(int r=0;r<16;++r)negm[r]=-mhat; asm volatile("":"+v"(negm)); \
        const float f=__builtin_amdgcn_exp2f(-dl); l_reg*=f; if(hi==0)wsf[r32]=f; resc=true; } } \
    SBAR(); \
    GAPB(o[0]=__builtin_amdgcn_mfma_f32_32x32x16_bf16(PAF(0),VFR(0),o[0],0,0,0), C0,0); \
    GAPB(o[1]=__builtin_amdgcn_mfma_f32_32x32x16_bf16(PAF(0),VFR(4),o[1],0,0,0), C0,4); \
    KRD(GL,0); GAPB(o[0]=__builtin_amdgcn_mfma_f32_32x32x16_bf16(PAF(1),VFR(1),o[0],0,0,0), C0,8); \
    KRD(GL,1); GAPB(o[1]=__builtin_amdgcn_mfma_f32_32x32x16_bf16(PAF(1),VFR(5),o[1],0,0,0), C0,12); \
    KRD(GL,2); GAPB(o[0]=__builtin_amdgcn_mfma_f32_32x32x16_bf16(PAF(2),VFR(2),o[0],0,0,0), C1,0); \
    KRD(GL,3); GAPB(o[1]=__builtin_amdgcn_mfma_f32_32x32x16_bf16(PAF(2),VFR(6),o[1],0,0,0), C1,4); \
    GAPB(o[0]=__builtin_amdgcn_mfma_f32_32x32x16_bf16(PAF(3),VFR(3),o[0],0,0,0), C1,8); \
    GAPB(o[1]=__builtin_amdgcn_mfma_f32_32x32x16_bf16(PAF(3),VFR(7),o[1],0,0,0), C1,12); \
    }while(0)
  int t=1;
  #undef CMASK
  #define CMASK(P0,P1,t) do{}while(0)
  for(;t+5<NT;t+=2){
    STEP(pB0,pB1,pA0,pA1,t,true,true,true);     WAIT_BAR(2); RESC(); ROT();
    STEP(pA0,pA1,pB0,pB1,t+1,true,true,true);   WAIT_BAR(2); RESC(); ROT();
  }
  #undef CMASK
  #define CMASK(P0,P1,t) do{}while(0)
  #define ENDW(tt) do{ if((tt)+3<NT){WAIT_BAR(2);} else if((tt)+2<NT){WAIT_BAR(1);} else {WAIT_BAR(0);} }while(0)
  for(;t+1<NT;t+=2){
    STEP(pB0,pB1,pA0,pA1,t,(t+3<NT),(t+1<NT),(t+1<NT));       ENDW(t);   RESC(); ROT();
    STEP(pA0,pA1,pB0,pB1,t+1,(t+4<NT),(t+2<NT),(t+2<NT));     ENDW(t+1); RESC(); ROT();
  }
  STEP(pB0,pB1,pA0,pA1,NT-1,false,false,false); RESC();
  { float sacc=pB0[0]+pB0[1]; _Pragma("unroll") for(int r=2;r<16;++r)sacc+=pB0[r]; _Pragma("unroll") for(int r=0;r<16;++r)sacc+=pB1[r]; l_reg+=sacc;
    pw0=(u32x4){PKW(pB0,0),PKW(pB0,2),PKW(pB0,4),PKW(pB0,6)};pw1=(u32x4){PKW(pB0,8),PKW(pB0,10),PKW(pB0,12),PKW(pB0,14)};pw2=(u32x4){PKW(pB1,0),PKW(pB1,2),PKW(pB1,4),PKW(pB1,6)};pw3=(u32x4){PKW(pB1,8),PKW(pB1,10),PKW(pB1,12),PKW(pB1,14)};
    SBAR(); pv(o,vb0+sl_cur,PAF(0),PAF(1),PAF(2),PAF(3)); }
  #undef PKW
  #undef PAF
  #undef VFR
  #undef PIN
  #undef MX3
  #undef GAPA
  #undef GAPB
  #undef EX
  #undef VRD
  #undef KRD
  #undef STEP
  #undef ENDW
  {auto rr=__builtin_amdgcn_permlane32_swap(__float_as_uint(l_reg),__float_as_uint(l_reg),false,false);l_reg=__uint_as_float(rr[0])+__uint_as_float(rr[1]);}
  if(hi==0)wsf[32+r32]=l_reg;asm volatile("s_waitcnt lgkmcnt(0)":::"memory");
  float rli[16];
  #pragma unroll
  for(int r=0;r<16;++r)rli[r]=__builtin_amdgcn_rcpf(wsf[32+crow(r,hi)]);
  bf16*Ow=Ob+(long)(wid*QBLK)*DM;
  { bf16*stg=(bf16*)(shm+LDS_OST)+wid*2048;
    #pragma unroll
    for(int r=0;r<16;++r){const int orow=crow(r,hi);
      #pragma unroll
      for(int d0=0;d0<2;++d0)stg[orow*64+d0*32+r32]=__float2bfloat16(o[d0][r]*rli[r]);}
    asm volatile("s_waitcnt lgkmcnt(0)":::"memory");
    #pragma unroll
    for(int i=0;i<4;++i){const int row=i*8+(lane>>3),ch=lane&7; const u32x4 v=*(const u32x4*)(stg+row*64+ch*8); ATTN_STORE16(Ow+(long)row*DM+ch*8,v);} }
  asm volatile("s_waitcnt lgkmcnt(0)\n\ts_barrier":::"memory");
  #undef DMA_K
  #undef KVROW
  #undef DMA_V
  #undef CMASK
  #undef START
  #undef RESC
  #undef ROT
}
#undef SBAR
#undef WAIT_BAR
}
#ifndef DIS
#define DIS 0
#endif
namespace cg = cooperative_groups;
#define LAS __attribute__((address_space(3)))
typedef unsigned short bf16;
typedef unsigned v4u __attribute__((ext_vector_type(4)));
typedef unsigned v2u __attribute__((ext_vector_type(2)));
typedef float f32x4 __attribute__((ext_vector_type(4)));
typedef float f32x2 __attribute__((ext_vector_type(2)));
typedef unsigned short bf16_;
#define RLX_AGENT __ATOMIC_RELAXED, __HIP_MEMORY_SCOPE_AGENT
#define LDS_WAIT() asm volatile("s_waitcnt lgkmcnt(0)" ::: "memory")
#define VM_WAIT() asm volatile("s_waitcnt vmcnt(0)" ::: "memory")
#define XB_TMO      128
#define XB_XCNT(j)  (256  + 64 * (j))
#define XB_XSUB(j)  (1280 + 64 * (j))
#define XB_XGEN(j)  (2304 + 64 * (j))
#define XB_TOP      3328
#define XB_TOPGEN   3392
#define XCD_BAR_WORDS 3456
#define XB_SPIN_CAP (1u << 18)

__device__ __forceinline__ unsigned xb_ld(unsigned* p)              { return __hip_atomic_load(p, __ATOMIC_RELAXED, __HIP_MEMORY_SCOPE_AGENT); }
__device__ __forceinline__ unsigned xb_add(unsigned* p, unsigned v) { return __hip_atomic_fetch_add(p, v, __ATOMIC_RELAXED, __HIP_MEMORY_SCOPE_AGENT); }
__device__ __forceinline__ unsigned xb_xcc_id() { return (unsigned)__builtin_amdgcn_s_getreg((3 << 11) | 20) & 0xFu; }
#define XB_SPIN(cond, bar) do { unsigned _sp = 0; while (cond) { __builtin_amdgcn_s_sleep(1); \
    if ((++_sp & 255u) == 0u) { if (xb_ld(&(bar)[XB_TMO])) break; if (_sp > XB_SPIN_CAP) { atomicAdd(&(bar)[XB_TMO], 1u); break; } } } } while (0)

struct XcdBarrier {
    unsigned* bar; unsigned x;
    volatile LAS unsigned* st;
};

__device__ __forceinline__ XcdBarrier xcd_barrier_post(unsigned* bar, volatile LAS unsigned* st) {
    XcdBarrier b; b.bar = bar; b.x = xb_xcc_id(); b.st = st;
    if (threadIdx.x == 0) (void)xb_add(&bar[XB_XCNT(b.x)], 1u);
    return b;
}
__device__ __forceinline__ void xcd_barrier_complete(unsigned* bar, unsigned x, unsigned& nloc, unsigned& nx) {
    const unsigned G = gridDim.x * gridDim.y * gridDim.z;
    unsigned sum, cnt, mine, sp = 0u;
    for (;;) {
        sum = 0u; cnt = 0u; mine = 0u;
#pragma unroll
        for (unsigned j = 0; j < 16; ++j) { const unsigned c = xb_ld(&bar[XB_XCNT(j)]); sum += c; cnt += (c > 0u) ? 1u : 0u; mine = (j == x) ? c : mine; }
        if (sum == G) break;
        __builtin_amdgcn_s_sleep(1);
        if ((++sp & 255u) == 0u) { if (xb_ld(&bar[XB_TMO])) break; if (sp > XB_SPIN_CAP) { atomicAdd(&bar[XB_TMO], 1u); break; } }
    }
    nloc = mine > 0u ? mine : 1u; nx = cnt > 0u ? cnt : 1u;
}

__device__ __forceinline__ void xcd_barrier(const XcdBarrier& b) {
    asm volatile("s_waitcnt vmcnt(0)" ::: "memory");
    __syncthreads();
    if (threadIdx.x == 0) {
        unsigned* bar = b.bar;
        __builtin_amdgcn_s_waitcnt(0);
        unsigned nloc = b.st[0], nx = b.st[1];
        if (nloc == 0u) { xcd_barrier_complete(bar, b.x, nloc, nx); b.st[0] = nloc; b.st[1] = nx; }
        const unsigned old = xb_add(&bar[XB_XSUB(b.x)], 1u);
        const unsigned gen = old / nloc;
        if (old + 1u == (gen + 1u) * nloc) {
            __builtin_amdgcn_fence(__ATOMIC_RELEASE, "agent");
            asm volatile("s_waitcnt vmcnt(0)" ::: "memory");
            const unsigned og = xb_add(&bar[XB_TOP], 1u);
            const unsigned tg = og / nx;
            if (og + 1u == (tg + 1u) * nx) xb_add(&bar[XB_TOPGEN], 1u);
            else XB_SPIN(xb_ld(&bar[XB_TOPGEN]) == tg, bar);
            __builtin_amdgcn_fence(__ATOMIC_ACQUIRE, "agent");
            xb_add(&bar[XB_XGEN(b.x)], 1u);
            asm volatile("s_waitcnt vmcnt(0)" ::: "memory");
        } else {
            XB_SPIN(xb_ld(&bar[XB_XGEN(b.x)]) == gen, bar);
            __builtin_amdgcn_fence(__ATOMIC_ACQUIRE, "agent");
            asm volatile("s_waitcnt vmcnt(0)" ::: "memory");
        }
    }
    __syncthreads();
}
constexpr int NWAVES = 8;
constexpr int DM = 1024, NBATCH = 8, SEQ = 2048, CTXL = 256, MX = NBATCH * SEQ, MC = NBATCH * CTXL, MT = MX + MC;
constexpr int DFF = 2816, DEPTH = 4, NMODV = 6, MODW = NMODV * DM;
constexpr float EPS = 1e-6f;
constexpr size_t MiB = 1u << 20;
constexpr size_t WS_CTL = 0, WS_MOD = 1 * MiB, WS_ROPE = 2 * MiB, WS_SSQ = 3 * MiB, WS_PW1T = 5 * MiB, WS_PW2T = 13 * MiB, WS_QKVT = 17 * MiB, WS_WOT = 23 * MiB, WS_W13T = 27 * MiB, WS_W2T = 71 * MiB,
                 WS_X = 93 * MiB, WS_Y = 165 * MiB, WS_H = 237 * MiB, WS_G = 273 * MiB, WS_END = 372 * MiB;
constexpr size_t WS_U = WS_G, WS_CV = WS_G + 36 * MiB, WS_KB = WS_G + 36 * MiB, WS_VB = WS_G + 45 * MiB;
constexpr int RING_BYTES = 131072, LDS_BYTES = 147456, MISC_OFF = RING_BYTES + 320;
constexpr int CW_BAR = 4096;
constexpr int N_PHASES = 2 + 7 * DEPTH;

__device__ __forceinline__ unsigned f2bf(float f) { unsigned u = __builtin_bit_cast(unsigned, f); return (u + 0x7fffu + ((u >> 16) & 1u)) >> 16; }
__device__ __forceinline__ unsigned pk2(float lo, float hi) { return f2bf(lo) | (f2bf(hi) << 16); }
__device__ __forceinline__ float wave_sum(float v) {
#pragma unroll
    for (int o = 1; o < 64; o <<= 1) v += __shfl_xor(v, o);
    return v;
}
struct Args { const float* in[24]; float* out; unsigned char* ws; int ph_lo, ph_hi; };
struct Frame {
    LAS unsigned char* lds;
    int tid, lane, wave, vcu, G;
    float* out; unsigned char* ws;
};
__device__ __forceinline__ void transpose_item(const float* W, int N, bf16* WT, int KT, int dst_row0, LAS float* scr, int k0, int n0, int lane) {
#pragma unroll 8
    for (int i = 0; i < 32; ++i) { const int kk = 2 * i + (lane >> 5); scr[kk * 33 + (lane & 31)] = W[(size_t)(k0 + kk) * N + n0 + (lane & 31)]; }
    asm volatile("s_waitcnt lgkmcnt(0)" ::: "memory");
    const int c = lane & 7;
#pragma unroll
    for (int j = 0; j < 4; ++j) { const int n = (lane >> 3) + 8 * j; const LAS float* s = scr + (8 * c) * 33 + n;
        v4u o; o.x = pk2(s[0 * 33], s[1 * 33]); o.y = pk2(s[2 * 33], s[3 * 33]); o.z = pk2(s[4 * 33], s[5 * 33]); o.w = pk2(s[6 * 33], s[7 * 33]);
        *(v4u*)(WT + (size_t)(dst_row0 + n) * KT + k0 + 8 * c) = o; }
    asm volatile("s_waitcnt lgkmcnt(0)" ::: "memory");
}
__device__ __forceinline__ int map_row(int kind, int n0) {
    if (kind == 0) return n0;
    if (kind == 1) { const int bj = n0 >> 10, rem = n0 & 1023; return 256 * (rem >> 7) + 128 * bj + (rem & 127); }
    if (kind == 2) return 256 * (n0 >> 7) + (n0 & 127);
    if (kind == 3) return 256 * (n0 >> 7) + 128 + (n0 & 127);
    const int head = n0 >> 6, bj = (n0 >> 5) & 1;
    if (kind == 4) return 256 * (head >> 2) + 128 * bj + 32 * (head & 3);
    if (kind == 5) return 1024 + 128 * bj + 32 * head;
    return 1280 + 128 * bj + 32 * head;
}
__device__ __forceinline__ void p0_prologue(Frame& F, const Args& args) {
    LAS float* scr = (LAS float*)(F.lds + F.wave * 16384);
    const int gw = F.vcu * NWAVES + F.wave, NGW = F.G * NWAVES;
    unsigned char* ws = F.ws;
    constexpr int I_PW1 = 16 * 64, I_SQ = 16 * 32, I_KV = 16 * 8, I_W1 = 16 * 88, I_W2 = 44 * 32;
    constexpr int I_CONV = I_PW1 + I_SQ, I_ATT = 2 * I_SQ + 2 * I_KV, I_FFN = 2 * I_W1 + I_W2;
    constexpr int NITEMS = 2 * I_CONV + 2 * I_ATT + 4 * I_FFN;
    for (int it = gw; it < NITEMS; it += NGW) {
        int r = it; const float* W; int K, N, kind; bf16* WT;
        if (r < 2 * I_CONV) { const int j = r / I_CONV; r -= j * I_CONV;
            if (r < I_PW1) { W = args.in[7] + (size_t)j * DM * 2 * DM; K = DM; N = 2 * DM; kind = 1; WT = (bf16*)(ws + WS_PW1T) + (size_t)j * 2 * DM * DM; }
            else { r -= I_PW1; W = args.in[13] + (size_t)j * DM * DM; K = DM; N = DM; kind = 0; WT = (bf16*)(ws + WS_PW2T) + (size_t)j * DM * DM; } }
        else if (r < 2 * I_CONV + 2 * I_ATT) { r -= 2 * I_CONV; const int j = r / I_ATT; r -= j * I_ATT; K = DM;
            bf16* qkv = (bf16*)(ws + WS_QKVT) + (size_t)j * 1536 * DM;
            if (r < I_SQ) { W = args.in[15] + (size_t)j * DM * DM; N = DM; kind = 4; WT = qkv; }
            else if (r < I_SQ + I_KV) { r -= I_SQ; W = args.in[16] + (size_t)j * DM * 256; N = 256; kind = 5; WT = qkv; }
            else if (r < I_SQ + 2 * I_KV) { r -= I_SQ + I_KV; W = args.in[17] + (size_t)j * DM * 256; N = 256; kind = 6; WT = qkv; }
            else { r -= I_SQ + 2 * I_KV; W = args.in[18] + (size_t)j * DM * DM; N = DM; kind = 0; WT = (bf16*)(ws + WS_WOT) + (size_t)j * DM * DM; } }
        else { r -= 2 * I_CONV + 2 * I_ATT; const int i = r / I_FFN; r -= i * I_FFN;
            bf16* w13 = (bf16*)(ws + WS_W13T) + (size_t)i * 2 * DFF * DM;
            if (r < I_W1) { W = args.in[21] + (size_t)i * DM * DFF; K = DM; N = DFF; kind = 2; WT = w13; }
            else if (r < 2 * I_W1) { r -= I_W1; W = args.in[22] + (size_t)i * DM * DFF; K = DM; N = DFF; kind = 3; WT = w13; }
            else { r -= 2 * I_W1; W = args.in[23] + (size_t)i * DFF * DM; K = DFF; N = DM; kind = 0; WT = (bf16*)(ws + WS_W2T) + (size_t)i * DM * DFF; } }
        const int nblk = N / 32, kb = r / nblk, nb = r % nblk;
        transpose_item(W, N, WT, K, map_row(kind, 32 * nb), scr, 64 * kb, 32 * nb, F.lane);
    }
    __syncthreads();
    if (blockIdx.x == 0) { float* tab = (float*)(ws + WS_ROPE);
        for (int idx = F.tid; idx < 64 * 16; idx += NWAVES * 64) { const int pos = idx >> 4, j = idx & 15; const float fr = powf(10000.0f, -(float)j * (1.0f / 16.0f)); const float ang = (float)pos * fr;
            tab[2 * idx] = cosf(ang); tab[2 * idx + 1] = sinf(ang); } }
    LAS float* sc = (LAS float*)F.lds;
    LAS float* red = sc + 9 * 1024;
    for (int idx = F.tid; idx < 9 * 1024; idx += NWAVES * 64) { const int mr = idx >> 10, k = idx & 1023; const float v = mr < 8 ? args.in[1][mr * DM + k] : args.in[3][k]; sc[idx] = v / (1.0f + __expf(-v)); }
    __syncthreads();
    float* mod = (float*)(ws + WS_MOD);
    for (int item = F.vcu; item < DEPTH * 48; item += F.G) {
        const int i = item / 48, cgp = item % 48;
        const float* W = args.in[4] + (size_t)i * DM * MODW + cgp * 128 + 2 * F.lane;
        float a0[9], a1[9];
#pragma unroll
        for (int mr = 0; mr < 9; ++mr) { a0[mr] = 0.f; a1[mr] = 0.f; }
        const int k0 = F.wave * 128;
#pragma unroll 8
        for (int kk = 0; kk < 128; ++kk) { const f32x2 w = *(const f32x2*)(W + (size_t)(k0 + kk) * MODW);
#pragma unroll
            for (int mr = 0; mr < 9; ++mr) { const float s = sc[mr * 1024 + k0 + kk]; a0[mr] += s * w.x; a1[mr] += s * w.y; } }
#pragma unroll
        for (int mr = 0; mr < 9; ++mr) { red[(F.wave * 9 + mr) * 128 + 2 * F.lane] = a0[mr]; red[(F.wave * 9 + mr) * 128 + 2 * F.lane + 1] = a1[mr]; }
        __syncthreads();
        for (int o = F.tid; o < 9 * 128; o += NWAVES * 64) { const int mr = o >> 7, col = o & 127; float s = 0.f;
#pragma unroll
            for (int w = 0; w < 8; ++w) s += red[(w * 9 + mr) * 128 + col];
            mod[(size_t)(i * 9 + mr) * MODW + cgp * 128 + col] = s + args.in[5][i * MODW + cgp * 128 + col]; }
        __syncthreads();
    }
}
struct RN { const float* xa; const float* xb; float* oa; float* ob; const float* Y; const float* ssq; const float* gate; const float* gpost; const float* gpre; const float* scm; const float* shm; bf16* H; int nrows; };
__device__ __forceinline__ void resnorm_phase(Frame& F, const RN a) {
    const int gw = F.vcu * NWAVES + F.wave, NGW = F.G * NWAVES; const int per = (a.nrows + NGW - 1) / NGW;
    const int r0 = gw * per, r1 = (r0 + per) < a.nrows ? (r0 + per) : a.nrows;
    const bool has_y = a.Y != nullptr, wr_x = a.oa != nullptr, wr_h = a.H != nullptr;
    int cur = -1; f32x4 A[4], Bv[4], Cv[4];
    for (int r = r0; r < r1; ++r) {
        const int mr = r < MX ? (r >> 11) : 8;
        if (mr != cur) { cur = mr;
#pragma unroll
            for (int j = 0; j < 4; ++j) { const int c = 4 * F.lane + 256 * j;
                if (has_y) A[j] = *(const f32x4*)(a.gate + (size_t)mr * MODW + c) * *(const f32x4*)(a.gpost + c);
                if (wr_h) { Bv[j] = *(const f32x4*)(a.gpre + c) * (*(const f32x4*)(a.scm + (size_t)mr * MODW + c) + 1.0f); Cv[j] = *(const f32x4*)(a.shm + (size_t)mr * MODW + c); } } }
        const float* xr = r < MX ? a.xa + (size_t)r * DM : a.xb + (size_t)(r - MX) * DM;
        f32x4 xv[4];
#pragma unroll
        for (int j = 0; j < 4; ++j) xv[j] = *(const f32x4*)(xr + 4 * F.lane + 256 * j);
        if (has_y) {
            f32x4 yv[4];
#pragma unroll
            for (int j = 0; j < 4; ++j) yv[j] = *(const f32x4*)(a.Y + (size_t)r * DM + 4 * F.lane + 256 * j);
            const float ss = wave_sum(F.lane < 16 ? a.ssq[(size_t)r * 16 + F.lane] : 0.f);
            const float inv = __builtin_amdgcn_rsqf(ss * (1.0f / DM) + EPS);
#pragma unroll
            for (int j = 0; j < 4; ++j) xv[j] = xv[j] + A[j] * (yv[j] * inv);
        }
        if (wr_x) { float* xo = r < MX ? a.oa + (size_t)r * DM : a.ob + (size_t)(r - MX) * DM;
#pragma unroll
            for (int j = 0; j < 4; ++j) *(f32x4*)(xo + 4 * F.lane + 256 * j) = xv[j]; }
        if (wr_h) {
            float s2 = 0.f;
#pragma unroll
            for (int j = 0; j < 4; ++j) s2 += (xv[j].x * xv[j].x + xv[j].y * xv[j].y) + (xv[j].z * xv[j].z + xv[j].w * xv[j].w);
            const float inv2 = __builtin_amdgcn_rsqf(wave_sum(s2) * (1.0f / DM) + EPS);
#pragma unroll
            for (int j = 0; j < 4; ++j) { const f32x4 h = xv[j] * inv2 * Bv[j] + Cv[j]; v2u w; w.x = pk2(h.x, h.y); w.y = pk2(h.z, h.w); *(v2u*)(a.H + (size_t)r * DM + 4 * F.lane + 256 * j) = w; }
        }
    }
}
__device__ __forceinline__ float bf_lo(unsigned v) { return __builtin_bit_cast(float, v << 16); }
__device__ __forceinline__ float bf_hi(unsigned v) { return __builtin_bit_cast(float, v & 0xffff0000u); }
__device__ __forceinline__ void conv_phase(Frame& F, const Args& args, int jc, const bf16* U, bf16* CV) {
    const int c0 = 2 * F.tid;
    float w0[31], w1[31];
#pragma unroll
    for (int k = 0; k < 31; ++k) { const f32x2 t = *(const f32x2*)(args.in[9] + (size_t)(jc * 31 + k) * DM + c0); w0[k] = t.x; w1[k] = t.y; }
    const f32x2 bdw = *(const f32x2*)(args.in[10] + jc * DM + c0), lng = *(const f32x2*)(args.in[11] + jc * DM + c0), lnb = *(const f32x2*)(args.in[12] + jc * DM + c0);
    LAS float* red = (LAS float*)F.lds;
    for (int item = F.vcu; item < MT / 8; item += F.G) {
        const int row0 = item * 8; int s0, L; if (row0 < MX) { s0 = row0 & ~(SEQ - 1); L = SEQ; } else { s0 = MX + ((row0 - MX) & ~(CTXL - 1)); L = CTXL; }
        const int t0 = row0 - s0;
        float a0[8], a1[8];
#pragma unroll
        for (int t = 0; t < 8; ++t) { a0[t] = bdw.x; a1[t] = bdw.y; }
#pragma unroll
        for (int r = 0; r < 38; ++r) { const int tt = t0 - 15 + r; float u0 = 0.f, u1 = 0.f;
            if (tt >= 0 && tt < L) { const unsigned v = *(const unsigned*)(U + (size_t)(s0 + tt) * DM + c0); u0 = bf_lo(v); u1 = bf_hi(v); }
#pragma unroll
            for (int t = 0; t < 8; ++t) { const int k = r - t; if (k >= 0 && k <= 30) { a0[t] += w0[k] * u0; a1[t] += w1[k] * u1; } } }
        float st[16];
#pragma unroll
        for (int t = 0; t < 8; ++t) { st[2 * t] = wave_sum(a0[t] + a1[t]); st[2 * t + 1] = wave_sum(a0[t] * a0[t] + a1[t] * a1[t]); }
        if (F.lane == 0) {
#pragma unroll
            for (int i = 0; i < 16; ++i) red[F.wave * 16 + i] = st[i]; }
        __syncthreads();
        if (F.tid < 16) { float s = 0.f;
#pragma unroll
            for (int w = 0; w < 8; ++w) s += red[w * 16 + F.tid];
            red[128 + F.tid] = s; }
        __syncthreads();
#pragma unroll
        for (int t = 0; t < 8; ++t) { const float mu = red[128 + 2 * t] * (1.0f / DM), var = red[128 + 2 * t + 1] * (1.0f / DM) - mu * mu; const float rstd = __builtin_amdgcn_rsqf(fmaxf(var, 0.f) + EPS);
            const float y0 = (a0[t] - mu) * rstd * lng.x + lnb.x, y1 = (a1[t] - mu) * rstd * lng.y + lnb.y;
            *(unsigned*)(CV + (size_t)(row0 + t) * DM + c0) = pk2(y0 / (1.0f + __expf(-y0)), y1 / (1.0f + __expf(-y1))); }
    }
    __syncthreads();
}

__global__ void __launch_bounds__(NWAVES * 64, 2) mk_fwd(Args args) {
    extern __shared__ __attribute__((aligned(16))) unsigned char lds[];

    for (int u = threadIdx.x; u < (LDS_BYTES - RING_BYTES) / 4; u += NWAVES * 64) ((LAS unsigned*)((LAS unsigned char*)lds + RING_BYTES))[u] = 0u;
    __syncthreads();
    const bool fused = args.ph_hi - args.ph_lo > 1;
    XcdBarrier bar; bar.bar = (unsigned*)(args.ws + WS_CTL) + CW_BAR; bar.x = 0; bar.st = nullptr;
    if (fused) bar = xcd_barrier_post((unsigned*)(args.ws + WS_CTL) + CW_BAR, (volatile LAS unsigned*)((LAS unsigned char*)lds + MISC_OFF) + 8);
    for (int ph = args.ph_lo; ph < args.ph_hi; ++ph) {
        unsigned char* ws = args.ws; asm volatile("" : "+s"(ws));
        Frame F;
        F.lds = (LAS unsigned char*)lds;
        { int t_ = threadIdx.x; asm volatile("" : "+v"(t_)); F.tid = t_; } F.lane = F.tid & 63; F.wave = __builtin_amdgcn_readfirstlane(F.tid >> 6);
        F.G = gridDim.x; { const int bx = blockIdx.x; F.vcu = (F.G % 8 == 0) ? (bx % 8) * (F.G / 8) + bx / 8 : bx; }
        F.out = args.out; F.ws = ws;
        float* const mod = (float*)(ws + WS_MOD); float* const X = (float*)(ws + WS_X); float* const Y = (float*)(ws + WS_Y); float* const SSQ = (float*)(ws + WS_SSQ);
        bf16* const H = (bf16*)(ws + WS_H); bf16* const U = (bf16*)(ws + WS_U); bf16* const CV = (bf16*)(ws + WS_CV); bf16* const KB = (bf16*)(ws + WS_KB); bf16* const VB = (bf16*)(ws + WS_VB); bf16* const GB = (bf16*)(ws + WS_G);
        const float* const normg = args.in[6];
        if (ph == 0) {
#if !(DIS & 1)
 p0_prologue(F, args);
#endif
 }
        else if (ph == 1) {
            RN a{args.in[0], args.in[2], nullptr, nullptr, nullptr, nullptr, nullptr, nullptr, normg, mod + 1 * DM, mod + 0 * DM, H, MT};
            resnorm_phase(F, a);
        } else {
            const int L = (ph - 2) / 7, sub = (ph - 2) % 7; const bool conv = (L & 1) == 0, last = (L == DEPTH - 1); const int jl = L >> 1;
            const int nMrows = last ? MX / 256 : MT / 256;
            if (sub == 0) {
                if (conv) {
                    pg8::Gemm g{H, (const bf16*)(ws + WS_PW1T) + (size_t)jl * 2 * DM * DM, MT, 2 * DM, DM}; pg8::TileOrder S; S.init(MT / 256, 8, 0, 0, 0, 1, F.G, (int)blockIdx.x);
                    pg8::EpiGate<0> E{U, DM, args.in[8] + jl * 2 * DM};
#if !(DIS & 2)
                    pg8::gemm_phase<pg8::EpiGate<0>, pg8::TileOrder, true, true>(F.lds, g, S, E);
#endif
                } else {
                    pg8::Gemm g{H, (const bf16*)(ws + WS_QKVT) + (size_t)jl * 1536 * DM, MT, 1536, DM}; pg8::TileOrder S;
                    if (last) S.init(MX / 256, 6, 2 * (MC / 256), MX / 256, 4, 2, F.G, (int)blockIdx.x); else S.init(MT / 256, 6, 0, 0, 0, 1, F.G, (int)blockIdx.x);
                    pg8::EpiQKV E{U, KB, VB, args.in[19] + jl * 64, args.in[20] + jl * 64, (const float*)(ws + WS_ROPE)};
#if !(DIS & 4)
                    pg8::gemm_phase<pg8::EpiQKV, pg8::TileOrder, true, true>(F.lds, g, S, E);
#endif
                }
            } else if (sub == 1) {
                if (conv) {
#if !(DIS & 8)
 conv_phase(F, args, jl, U, CV);
#endif
 }
                else {
                    const int nxu = NBATCH * 16 * (SEQ / 256), ncu = last ? 0 : NBATCH * 16;
                    for (int id = F.vcu; id < nxu + ncu; id += F.G) {
                        int b, h, NT, NTX; long qrow, xr0, cr0;
                        if (id < nxu) { b = id >> 7; h = (id >> 3) & 15; qrow = (long)b * SEQ + (id & 7) * 256; NT = 36; NTX = 32; xr0 = (long)b * SEQ; cr0 = MX + (long)b * CTXL; }
                        else { const int e = id - nxu; b = e >> 4; h = e & 15; qrow = MX + (long)b * CTXL; NT = 4; NTX = 0; xr0 = 0; cr0 = MX + (long)b * CTXL; }
#if !(DIS & 16)
                        attn_body::attn_unit<8>((const attn_body::bf16*)U + qrow * DM + h * 64, (const attn_body::bf16*)KB + (h >> 2) * 64, (const attn_body::bf16*)VB + (h >> 2) * 64,
                                                (attn_body::bf16*)U + qrow * DM + h * 64, NT, NTX, xr0, cr0, (char*)lds);
#endif
                    }
                }
            } else if (sub == 2 || sub == 5) {
                pg8::Gemm g; const float* bias = nullptr;
                if (sub == 5) g = pg8::Gemm{GB, (const bf16*)(ws + WS_W2T) + (size_t)L * DM * DFF, MT, DM, DFF};
                else if (conv) { g = pg8::Gemm{CV, (const bf16*)(ws + WS_PW2T) + (size_t)jl * DM * DM, MT, DM, DM}; bias = args.in[14] + jl * DM; }
                else g = pg8::Gemm{U, (const bf16*)(ws + WS_WOT) + (size_t)jl * DM * DM, MT, DM, DM};
                pg8::TileOrder S; S.init(nMrows, 4, 0, 0, 0, 1, F.G, (int)blockIdx.x);
                pg8::EpiY E{Y, SSQ, bias};
#if !(DIS & 32)
                pg8::gemm_phase<pg8::EpiY, pg8::TileOrder, true, true>(F.lds, g, S, E);
#endif
            } else if (sub == 3) {
                const float* ml = mod + (size_t)L * 9 * MODW;
                RN a{L == 0 ? args.in[0] : X, L == 0 ? args.in[2] : X + (size_t)MX * DM, X, X + (size_t)MX * DM, Y, SSQ, ml + 2 * DM, normg + (L * 4 + 1) * DM, normg + (L * 4 + 2) * DM, ml + 4 * DM, ml + 3 * DM, H, nMrows * 256};
                resnorm_phase(F, a);
            } else if (sub == 4) {
                pg8::Gemm g{H, (const bf16*)(ws + WS_W13T) + (size_t)L * 2 * DFF * DM, MT, 2 * DFF, DM}; pg8::TileOrder S; S.init(nMrows, 2 * DFF / 256, 0, 0, 0, 1, F.G, (int)blockIdx.x);
                pg8::EpiGate<1> E{GB, DFF, nullptr};
#if !(DIS & 64)
                pg8::gemm_phase<pg8::EpiGate<1>, pg8::TileOrder, true, true>(F.lds, g, S, E);
#endif
            } else {
                const float* ml = mod + (size_t)L * 9 * MODW; const float* mn = mod + (size_t)(L + 1) * 9 * MODW;
                RN a{X, X + (size_t)MX * DM, last ? F.out : X, X + (size_t)MX * DM, Y, SSQ, ml + 5 * DM, normg + (L * 4 + 3) * DM,
                     last ? nullptr : normg + ((L + 1) * 4 + 0) * DM, last ? nullptr : mn + 1 * DM, last ? nullptr : mn + 0 * DM, last ? nullptr : H, nMrows * 256};
                resnorm_phase(F, a);
            }
        }
        if (ph + 1 < args.ph_hi) { if (ph == args.ph_lo) cg::this_grid().sync(); else xcd_barrier(bar); }
    }
}

#ifndef DIS
#define DIS 0
#endif
#ifndef MK_MULTI
#define MK_MULTI 0
#endif
extern "C" void kernel_launch(void* const* d_in, const int* in_sizes, int n_in, void* d_out, int out_size, void* d_ws, size_t ws_size, hipStream_t stream) {
    static int grid = 0;
    if (grid == 0) {
        if (n_in != 24 || out_size != MX * DM || ws_size < WS_END) { fprintf(stderr, "kernel_launch: unexpected shapes: n_in %d out %d ws %zu (need %zu)\n", n_in, out_size, ws_size, (size_t)WS_END); grid = -1; return; }
        int dev = 0, cus = 0, per_cu = 0;
        if (hipGetDevice(&dev) != hipSuccess || hipDeviceGetAttribute(&cus, hipDeviceAttributeMultiprocessorCount, dev) != hipSuccess) { grid = -1; return; }
        if (hipFuncSetAttribute((const void*)mk_fwd, hipFuncAttributeMaxDynamicSharedMemorySize, LDS_BYTES) != hipSuccess) { fprintf(stderr, "kernel_launch: hipFuncSetAttribute failed\n"); grid = -1; return; }
        if (hipOccupancyMaxActiveBlocksPerMultiprocessor(&per_cu, (const void*)mk_fwd, NWAVES * 64, LDS_BYTES) != hipSuccess || per_cu < 1) { fprintf(stderr, "kernel_launch: occupancy query says %d blocks per CU\n", per_cu); per_cu = 1; }
        (void)hipGetLastError();
        grid = cus;
    }
    if (grid < 0) return;
    if (hipMemsetAsync((char*)d_ws + WS_CTL, 0, 64 * 1024, stream) != hipSuccess) { fprintf(stderr, "kernel_launch: memset failed\n"); return; }
    Args a{};
    for (int i = 0; i < 24; ++i) a.in[i] = (const float*)d_in[i];
    a.out = (float*)d_out; a.ws = (unsigned char*)d_ws;
#if MK_MULTI
    for (int ph = 0; ph < N_PHASES; ++ph) { a.ph_lo = ph; a.ph_hi = ph + 1; hipLaunchKernelGGL(mk_fwd, dim3(grid), dim3(NWAVES * 64), LDS_BYTES, stream, a); }
#else
    a.ph_lo = 0; a.ph_hi = N_PHASES;
    void* kargs[] = {&a};
    hipError_t e = hipLaunchCooperativeKernel((const void*)mk_fwd, dim3(grid), dim3(NWAVES * 64), kargs, LDS_BYTES, stream);
    if (e != hipSuccess) fprintf(stderr, "kernel_launch: cooperative launch failed: %s (grid %d)\n", hipGetErrorString(e), grid);
#endif
}
```

```cpp
#define MK_MULTI 0
#include <hip/hip_runtime.h>
#include <hip/hip_cooperative_groups.h>
#include <cstdio>
#include <cstdint>
namespace pg8 {
#define PG8_LAS __attribute__((address_space(3)))
typedef unsigned short bf16_t;
typedef short bf16x8 __attribute__((ext_vector_type(8)));
typedef float f32x4 __attribute__((ext_vector_type(4)));
typedef unsigned u32x4 __attribute__((ext_vector_type(4)));
constexpr int BM = 256, BK = 64, HALF = 128, HTB = HALF * BK * 2  , STAGE_BYTES = 8 * HTB, NXCD = 8, WGM = 8;

__host__ __device__ __forceinline__ int lds_byte(int r, int c) { const int st = (r >> 4) * 2 + (c >> 5), rr = r & 15, cc = c & 31, ob = rr * 64 + cc * 2; return st * 1024 + (ob ^ (((ob >> 9) & 1) << 5)); }
__host__ __device__ __forceinline__ void stage_rc(int b, int& R, int& C) { const int st = b / 1024, sb = b % 1024, swz = sb ^ (((sb >> 9) & 1) << 5); R = (st >> 1) * 16 + swz / 64; C = (st & 1) * 32 + (swz % 64) / 2; }
__host__ __device__ __forceinline__ int perm32(int rho) { const int n = rho >> 4, i = rho & 15; return 8 * (i >> 2) + 4 * n + (i & 3); }

struct Unit { int pm, pn, kb, nt; };
struct Gemm { const bf16_t* A; const bf16_t* Bt; int M, N, K; };

struct StaticOrder {
    int nM, nN, nwg, G, c;
    __host__ __device__ void init(int M, int N, int G_, int c_) { nM = M / BM; nN = N / BM; nwg = nM * nN; G = G_; c = c_; }
    __host__ __device__ bool next(int i, Unit& u) const {
        const long L = (long)i * G + c; if (L >= nwg) return false;
        int wgid = (int)L; { const int q = nwg / NXCD, r = nwg % NXCD, xcd = wgid % NXCD, off = wgid / NXCD; wgid = (xcd < r ? xcd * (q + 1) : r * (q + 1) + (xcd - r) * q) + off; }
        const int nig = WGM * nN, gid = wgid / nig, fm = gid * WGM, gsz = (nM - fm) < WGM ? (nM - fm) : WGM;
        u.pm = fm + ((wgid % nig) % gsz); u.pn = (wgid % nig) / gsz; return true;
    }
    __device__ __forceinline__ void a_ready(const Unit&) const {}
    __device__ __forceinline__ void done(const Unit&) const {}
};

__device__ __forceinline__ unsigned cvt_pk_bf16(float lo, float hi) { unsigned r; asm volatile("v_cvt_pk_bf16_f32 %0, %1, %2" : "=v"(r) : "v"(lo), "v"(hi)); return r; }
typedef float f32x2 __attribute__((ext_vector_type(2)));
struct TileOrder {
    int nM, nN, nmain, nextra, xpm0, xpn0, xw, ksplit, nts, ntfull, G, c;
    __device__ __forceinline__ void init(int nM_, int nN_, int ntfull_, int G_, int c_) { nM = nM_; nN = nN_; nmain = nM_ * nN_; ntfull = ntfull_; nextra = 0; xpm0 = 0; xpn0 = 0; xw = 1; ksplit = 1; nts = ntfull_; G = G_; c = c_; }
    __device__ __forceinline__ void extra(int ntile_x, int xpm0_, int xpn0_, int xw_, int ksplit_, int nts_) { nextra = ntile_x * ksplit_; xpm0 = xpm0_; xpn0 = xpn0_; xw = xw_; ksplit = ksplit_; nts = nts_; }
    __device__ __forceinline__ bool next(int i, Unit& u) const {
        const long L = (long)i * G + c; if (L >= nmain + nextra) return false;
        const bool ex = L >= nmain;
        const int e = ex ? (int)L - nmain : 0, tile = e / ksplit, sp = e % ksplit;
        const int epm = xpm0 + tile / xw, epn = xpn0 + tile % xw;
        const int rem = ntfull - sp * nts, ent = rem < nts ? rem : nts, ekb = sp * nts * BK;
        int wgid = ex ? 0 : (int)L; const int nwg = nmain; { const int q = nwg / NXCD, r = nwg % NXCD, xcd = wgid % NXCD, off = wgid / NXCD; wgid = (xcd < r ? xcd * (q + 1) : r * (q + 1) + (xcd - r) * q) + off; }
        const int nig = WGM * nN, gid = wgid / nig, fm = gid * WGM, gsz = (nM - fm) < WGM ? (nM - fm) : WGM;
        const int mpm = fm + ((wgid % nig) % gsz), mpn = (wgid % nig) / gsz;
        u.pm = ex ? epm : mpm; u.pn = ex ? epn : mpn; u.kb = ex ? ekb : 0; u.nt = ex ? ent : ntfull;
        return true;
    }
    __device__ __forceinline__ void a_ready(const Unit&) const {}
    __device__ __forceinline__ void done(const Unit&) const {}
};
__device__ __forceinline__ float sigmoidf_fast(float x) { return __builtin_amdgcn_rcpf(1.0f + __expf(-x)); }
template <int MODE> struct EpiGate {
    static constexpr bool PERM = true, AFTER_DRAIN = false;
    bf16_t* O; int ldc; const float* bias;
    __device__ __forceinline__ void operator()(const f32x4 (&acc)[2][2][4][2], const Unit& u, int wr, int wc, int fr, int fq) const {
        const int row0 = u.pm * BM + wr * 64 + fr, col0 = u.pn * 128 + wc * 32 + 8 * fq;
        f32x4 ba[2], bb[2];
#pragma unroll
        for (int n = 0; n < 2; ++n) { if (MODE == 0) { ba[n] = *(const f32x4*)(bias + col0 + 4 * n); bb[n] = *(const f32x4*)(bias + 1024 + col0 + 4 * n); } else { ba[n] = (f32x4){0.f, 0.f, 0.f, 0.f}; bb[n] = ba[n]; } }
#pragma unroll
        for (int ai = 0; ai < 2; ++ai)
#pragma unroll
            for (int m = 0; m < 4; ++m) {
                float o[8];
#pragma unroll
                for (int n = 0; n < 2; ++n) { const f32x4 a = acc[ai][0][m][n] + ba[n], b = acc[ai][1][m][n] + bb[n];
#pragma unroll
                    for (int e = 0; e < 4; ++e) o[4 * n + e] = (MODE == 0) ? a[e] * sigmoidf_fast(b[e]) : a[e] * sigmoidf_fast(a[e]) * b[e]; }
                u32x4 w; w.x = cvt_pk_bf16(o[0], o[1]); w.y = cvt_pk_bf16(o[2], o[3]); w.z = cvt_pk_bf16(o[4], o[5]); w.w = cvt_pk_bf16(o[6], o[7]);
                *(u32x4*)(O + (size_t)(row0 + ai * HALF + m * 16) * ldc + col0) = w;
            }
    }
};
struct EpiY {
    static constexpr bool PERM = true, AFTER_DRAIN = false;
    float* Y; float* P; const float* bias; int ntfull, pshift;
    __device__ __forceinline__ void operator()(const f32x4 (&acc)[2][2][4][2], const Unit& u, int wr, int wc, int fr, int fq) const {
        const int row0 = u.pm * BM + wr * 64 + fr, col0 = u.pn * BM + wc * 32 + 8 * fq;
        const bool isp = u.nt < ntfull;
        float* base = isp ? P + ((size_t)(u.kb >> pshift) * 2048 + (size_t)(row0 - 16384)) * 1024 + col0 : Y + (size_t)row0 * 1024 + col0;
        const bool wb = bias != nullptr && u.kb == 0;
        f32x4 bv[2][2];
#pragma unroll
        for (int bj = 0; bj < 2; ++bj)
#pragma unroll
            for (int n = 0; n < 2; ++n) bv[bj][n] = wb ? *(const f32x4*)(bias + col0 + bj * HALF + 4 * n) : (f32x4){0.f, 0.f, 0.f, 0.f};
#pragma unroll
        for (int ai = 0; ai < 2; ++ai)
#pragma unroll
            for (int m = 0; m < 4; ++m) { float* yp = base + (size_t)(ai * HALF + m * 16) * 1024;
#pragma unroll
                for (int bj = 0; bj < 2; ++bj)
#pragma unroll
                    for (int n = 0; n < 2; ++n) *(f32x4*)(yp + bj * HALF + 4 * n) = acc[ai][bj][m][n] + bv[bj][n]; }
    }
};
struct EpiQKV {
    static constexpr bool PERM = true, AFTER_DRAIN = false;
    bf16_t *Q, *Kb, *Vb; const float *qg, *kg; const float* rope;
    __device__ __forceinline__ void operator()(const f32x4 (&acc)[2][2][4][2], const Unit& u, int wr, int wc, int fr, int fq) const {
        const int pn = u.pn, row0 = u.pm * BM + wr * 64 + fr; const bool isx = u.pm < 64;
        if (pn == 5) {
#pragma unroll
            for (int ai = 0; ai < 2; ++ai)
#pragma unroll
                for (int m = 0; m < 4; ++m) { bf16_t* dst = Vb + (size_t)(row0 + ai * HALF + m * 16) * 256 + wc * 64 + 8 * fq;
#pragma unroll
                    for (int bj = 0; bj < 2; ++bj) { const f32x4 a = acc[ai][bj][m][0], b = acc[ai][bj][m][1]; u32x4 w; w.x = cvt_pk_bf16(a[0], a[1]); w.y = cvt_pk_bf16(a[2], a[3]); w.z = cvt_pk_bf16(b[0], b[1]); w.w = cvt_pk_bf16(b[2], b[3]);
                        *(u32x4*)(dst + 32 * bj) = w; } }
            return;
        }
        const bool isq = pn < 4; const float* gp = (isq ? qg : kg) + 8 * fq; const float osc = isq ? 0.125f * 1.4426950408889634f : 1.0f;
        f32x4 gv[2][2];
#pragma unroll
        for (int bj = 0; bj < 2; ++bj)
#pragma unroll
            for (int n = 0; n < 2; ++n) gv[bj][n] = *(const f32x4*)(gp + 32 * bj + 4 * n) * osc;
#pragma unroll
        for (int ai = 0; ai < 2; ++ai) {
            f32x4 cs0[2] = {(f32x4){1.f, 0.f, 1.f, 0.f}, (f32x4){1.f, 0.f, 1.f, 0.f}};
            if (isx) { const int posr = 4 * (u.pm & 7) + 2 * ai + wr; const float* rp = rope + (size_t)(posr * 16 + 4 * fq) * 2; cs0[0] = *(const f32x4*)rp; cs0[1] = *(const f32x4*)(rp + 4); }
#pragma unroll
            for (int m = 0; m < 4; ++m) {
                const int row = row0 + ai * HALF + m * 16;
                float ss = 0.f;
#pragma unroll
                for (int bj = 0; bj < 2; ++bj)
#pragma unroll
                    for (int n = 0; n < 2; ++n) { const f32x4 v = acc[ai][bj][m][n]; ss += (v[0] * v[0] + v[1] * v[1]) + (v[2] * v[2] + v[3] * v[3]); }
                ss += __shfl_xor(ss, 16); ss += __shfl_xor(ss, 32);
                const float inv = __builtin_amdgcn_rsqf(ss * (1.0f / 64.0f) + 1e-6f);
                f32x4 cs1[2] = {(f32x4){1.f, 0.f, 1.f, 0.f}, (f32x4){1.f, 0.f, 1.f, 0.f}};
                if (isx) { const int posc = 16 * m + fr; const float* rp = rope + (size_t)(posc * 16 + 4 * fq) * 2; cs1[0] = *(const f32x4*)rp; cs1[1] = *(const f32x4*)(rp + 4); }
                bf16_t* dst = isq ? (Q + (size_t)row * 1024 + (4 * pn + wc) * 64 + 8 * fq) : (Kb + (size_t)row * 256 + wc * 64 + 8 * fq);
#pragma unroll
                for (int bj = 0; bj < 2; ++bj) { float o[8];
#pragma unroll
                    for (int n = 0; n < 2; ++n) { const f32x4 v = acc[ai][bj][m][n] * inv * gv[bj][n]; const f32x4 cs = bj == 0 ? cs0[n] : cs1[n];
                        o[4 * n + 0] = v[0] * cs[0] - v[1] * cs[1]; o[4 * n + 1] = v[0] * cs[1] + v[1] * cs[0];
                        o[4 * n + 2] = v[2] * cs[2] - v[3] * cs[3]; o[4 * n + 3] = v[2] * cs[3] + v[3] * cs[2]; }
                    u32x4 w; w.x = cvt_pk_bf16(o[0], o[1]); w.y = cvt_pk_bf16(o[2], o[3]); w.z = cvt_pk_bf16(o[4], o[5]); w.w = cvt_pk_bf16(o[6], o[7]);
                    *(u32x4*)(dst + 32 * bj) = w; }
            }
        }
    }
};

template <class Epi, class Sched, bool ALIGN_EPI = false, bool SP2 = false>
__device__ __forceinline__ void gemm_phase(PG8_LAS unsigned char* lds, const Gemm g, const Sched& S, const Epi& E) {
    int tid_ = threadIdx.x; asm volatile("" : "+v"(tid_)); const int tid = tid_, wid = __builtin_amdgcn_readfirstlane(tid >> 6), lane = tid & 63, wr = wid >> 2, wc = wid & 3, fr = lane & 15, fq = lane >> 4;
    const int K = g.K, nt = K / BK;
    unsigned voffA[2], voffB[2];
#pragma unroll
    for (int i = 0; i < 2; ++i) { int R, C; stage_rc(tid * 16 + i * 8192, R, C); const int Rb = Epi::PERM ? ((R & ~31) + perm32(R & 31)) : R;
        voffA[i] = (unsigned)(R * K + C) * 2u; voffB[i] = (unsigned)(Rb * K + C) * 2u; }
    const size_t kstep = (size_t)(BK * 2);
    const size_t hstep = (size_t)HALF * K * 2;
    const size_t tstep = 2 * hstep;
    const unsigned ldsw = (unsigned)wid * 1024u;
    const int aoff = lds_byte(wr * 64 + fr, fq * 8), boff = lds_byte(wc * 32 + fr, fq * 8);
#define PG8_SA(b, h) (((b) * 2 + (h)) * HTB)
#define PG8_SB(b, h) ((4 + (b) * 2 + (h)) * HTB)
#define PG8_STAGE(bufoff, gbase, voff) do { _Pragma("unroll") for (int _i = 0; _i < 2; ++_i) \
        __builtin_amdgcn_global_load_lds((const unsigned*)((const char*)(gbase) + (voff)[_i]), (PG8_LAS unsigned*)(lds + (bufoff) + ldsw + _i * 8192), 16, 0, 0); } while (0)
#define PG8_LDA(dst, b, h) do { _Pragma("unroll") for (int m = 0; m < 4; ++m) _Pragma("unroll") for (int k = 0; k < 2; ++k) dst[m][k] = *(const PG8_LAS bf16x8*)(lds + PG8_SA(b, h) + aoff + m * 2048 + k * 1024); } while (0)
#define PG8_LDB(dst, b, h) do { _Pragma("unroll") for (int n = 0; n < 2; ++n) _Pragma("unroll") for (int k = 0; k < 2; ++k) dst[n][k] = *(const PG8_LAS bf16x8*)(lds + PG8_SB(b, h) + boff + n * 2048 + k * 1024); } while (0)
#define PG8_MMA(ai, bj, At, Bt) do { __builtin_amdgcn_s_setprio(1); _Pragma("unroll") for (int m = 0; m < 4; ++m) _Pragma("unroll") for (int n = 0; n < 2; ++n) _Pragma("unroll") for (int k = 0; k < 2; ++k) \
        acc[ai][bj][m][n] = __builtin_amdgcn_mfma_f32_16x16x32_bf16(Bt[n][k], At[m][k], acc[ai][bj][m][n], 0, 0, 0); __builtin_amdgcn_s_setprio(0); } while (0)
#define PG8_WAIT_V(n) asm volatile("s_waitcnt vmcnt(" #n ")" ::: "memory")
#define PG8_WAIT_L(n) asm volatile("s_waitcnt lgkmcnt(" #n ")" ::: "memory")
#define PG8_BAR __builtin_amdgcn_s_barrier()
#define PG8_SCHED __builtin_amdgcn_sched_barrier(0)
    Unit cur, nxt; int ui = 0;
    if (!S.next(0, cur)) return;
    f32x4 acc[2][2][4][2];
#pragma unroll
    for (int a = 0; a < 2; ++a)
#pragma unroll
        for (int b = 0; b < 2; ++b)
#pragma unroll
            for (int m = 0; m < 4; ++m)
#pragma unroll
                for (int n = 0; n < 2; ++n) acc[a][b][m][n] = (f32x4){0.f, 0.f, 0.f, 0.f};
    bf16x8 At[4][2], B0[2][2], B1[2][2];
    const char* cA = (const char*)g.A + (size_t)cur.pm * tstep + (size_t)cur.kb * 2; const char* cB = (const char*)g.Bt + (size_t)cur.pn * tstep + (size_t)cur.kb * 2;
    S.a_ready(cur);
    if constexpr (SP2) {
        PG8_STAGE(PG8_SB(0, 0), cB, voffB); PG8_STAGE(PG8_SB(0, 1), cB + hstep, voffB); PG8_STAGE(PG8_SA(0, 0), cA, voffA); PG8_STAGE(PG8_SA(0, 1), cA + hstep, voffA);
        if (wr == 1) PG8_BAR;
        PG8_WAIT_V(2); PG8_BAR;
        PG8_STAGE(PG8_SB(1, 0), cB + kstep, voffB); PG8_STAGE(PG8_SA(1, 0), cA + kstep, voffA); PG8_STAGE(PG8_SB(1, 1), cB + hstep + kstep, voffB);
        PG8_WAIT_V(6); PG8_BAR;
    } else {
        PG8_STAGE(PG8_SB(0, 0), cB, voffB); PG8_STAGE(PG8_SA(0, 0), cA, voffA); PG8_STAGE(PG8_SB(0, 1), cB + hstep, voffB); PG8_STAGE(PG8_SA(0, 1), cA + hstep, voffA);
        if (wr == 1) PG8_BAR;
        PG8_WAIT_V(4); PG8_BAR;
        PG8_STAGE(PG8_SB(1, 0), cB + kstep, voffB); PG8_STAGE(PG8_SA(1, 0), cA + kstep, voffA); PG8_STAGE(PG8_SB(1, 1), cB + hstep + kstep, voffB);
        PG8_WAIT_V(6); PG8_BAR;
    }
    for (;;) {
        const bool has_next = S.next(ui + 1, nxt);
        const char* nA = has_next ? (const char*)g.A + (size_t)nxt.pm * tstep + (size_t)nxt.kb * 2 : cA; const char* nB = has_next ? (const char*)g.Bt + (size_t)nxt.pn * tstep + (size_t)nxt.kb * 2 : cB;
        const int cnt = cur.nt;
        for (int t = 0; t < cnt; t += 2) {
            const bool last = (t == cnt - 2);
            const char* a1 = cA + (size_t)(t + 1) * kstep;
            const char* a2 = last ? nA : cA + (size_t)(t + 2) * kstep; const char* b2 = last ? nB : cB + (size_t)(t + 2) * kstep;
            const char* a3 = a2 + kstep; const char* b3 = b2 + kstep;
            if (last && has_next) S.a_ready(nxt);
            if constexpr (SP2) {
            PG8_LDB(B0, 0, 0); PG8_LDB(B1, 0, 1); PG8_SCHED; PG8_LDA(At, 0, 0); PG8_STAGE(PG8_SA(1, 1), a1 + hstep, voffA);
            PG8_WAIT_V(8); PG8_WAIT_L(0); PG8_BAR; PG8_MMA(0, 0, At, B0); PG8_MMA(0, 1, At, B1); PG8_BAR; PG8_SCHED;
            PG8_LDA(At, 0, 1); PG8_STAGE(PG8_SB(0, 0), b2, voffB); PG8_STAGE(PG8_SB(0, 1), b2 + hstep, voffB); PG8_STAGE(PG8_SA(0, 0), a2, voffA);
            PG8_WAIT_V(8); PG8_WAIT_L(0); PG8_BAR; PG8_MMA(1, 0, At, B0); PG8_MMA(1, 1, At, B1); PG8_BAR; PG8_SCHED;
            PG8_LDB(B0, 1, 0); PG8_LDB(B1, 1, 1); PG8_SCHED; PG8_LDA(At, 1, 0); PG8_STAGE(PG8_SA(0, 1), a2 + hstep, voffA);
            PG8_WAIT_V(8); PG8_WAIT_L(0); PG8_BAR; PG8_MMA(0, 0, At, B0); PG8_MMA(0, 1, At, B1); PG8_BAR; PG8_SCHED;
            PG8_LDA(At, 1, 1); PG8_STAGE(PG8_SB(1, 0), b3, voffB); PG8_STAGE(PG8_SB(1, 1), b3 + hstep, voffB); PG8_STAGE(PG8_SA(1, 0), a3, voffA);
            PG8_WAIT_V(8); PG8_WAIT_L(0); PG8_BAR; PG8_MMA(1, 0, At, B0); PG8_MMA(1, 1, At, B1); PG8_BAR; PG8_SCHED;
            } else {
            PG8_LDB(B0, 0, 0); PG8_SCHED; PG8_LDA(At, 0, 0); PG8_STAGE(PG8_SA(1, 1), a1 + hstep, voffA);
            PG8_WAIT_L(8); PG8_BAR; PG8_WAIT_L(0); PG8_MMA(0, 0, At, B0); PG8_BAR; PG8_SCHED;
            PG8_LDB(B1, 0, 1); PG8_STAGE(PG8_SB(0, 0), b2, voffB);
            PG8_BAR; PG8_WAIT_L(0); PG8_MMA(0, 1, At, B1); PG8_BAR;
            PG8_LDA(At, 0, 1); PG8_STAGE(PG8_SA(0, 0), a2, voffA);
            PG8_BAR; PG8_WAIT_L(0); PG8_MMA(1, 0, At, B0); PG8_BAR; PG8_SCHED;
            PG8_STAGE(PG8_SB(0, 1), b2 + hstep, voffB);
            PG8_WAIT_V(6); PG8_BAR; PG8_MMA(1, 1, At, B1); PG8_BAR;
            PG8_LDB(B0, 1, 0); PG8_SCHED; PG8_LDA(At, 1, 0); PG8_STAGE(PG8_SA(0, 1), a2 + hstep, voffA);
            PG8_WAIT_L(8); PG8_BAR; PG8_WAIT_L(0); PG8_MMA(0, 0, At, B0); PG8_BAR; PG8_SCHED;
            PG8_LDB(B1, 1, 1); PG8_STAGE(PG8_SB(1, 0), b3, voffB);
            PG8_BAR; PG8_WAIT_L(0); PG8_MMA(0, 1, At, B1); PG8_BAR;
            PG8_LDA(At, 1, 1); PG8_STAGE(PG8_SA(1, 0), a3, voffA);
            PG8_BAR; PG8_WAIT_L(0); PG8_MMA(1, 0, At, B0); PG8_BAR; PG8_SCHED;
            PG8_STAGE(PG8_SB(1, 1), b3 + hstep, voffB);
            PG8_WAIT_V(6); PG8_BAR; PG8_MMA(1, 1, At, B1); PG8_BAR;
            }
        }
        if constexpr (ALIGN_EPI) { if (wr == 0) PG8_BAR; }
        if constexpr (!Epi::AFTER_DRAIN) { E(acc, cur, wr, wc, fr, fq); S.done(cur); }
        if (!has_next) break;
#pragma unroll
        for (int a = 0; a < 2; ++a)
#pragma unroll
            for (int b = 0; b < 2; ++b)
#pragma unroll
                for (int m = 0; m < 4; ++m)
#pragma unroll
                    for (int n = 0; n < 2; ++n) acc[a][b][m][n] = (f32x4){0.f, 0.f, 0.f, 0.f};
        cur = nxt; cA = nA; cB = nB; ++ui;
        if constexpr (ALIGN_EPI) { if (wr == 1) PG8_BAR; }
    }
    PG8_WAIT_V(0);
    if constexpr (!ALIGN_EPI) { if (wr == 0) PG8_BAR; }
    PG8_BAR;
    if constexpr (Epi::AFTER_DRAIN) { E.fused(acc, cur, wr, wc, fr, fq, lds, wid, lane); S.done(cur); }
#undef PG8_SA
#undef PG8_SB
#undef PG8_STAGE
#undef PG8_LDA
#undef PG8_LDB
#undef PG8_MMA
#undef PG8_WAIT_V
#undef PG8_WAIT_L
#undef PG8_BAR
#undef PG8_SCHED
}
}
#include <hip/hip_bf16.h>
#include <cmath>
namespace attn_body {
using bf16=__hip_bfloat16;
using bf16x8=__attribute__((ext_vector_type(8)))short;
using s16x4=__attribute__((ext_vector_type(4)))short;
using f32x16=__attribute__((ext_vector_type(16)))float;
using u32x4=__attribute__((ext_vector_type(4)))unsigned;
constexpr int D=64,DM=1024,KVP=256;
constexpr int NW=8,QBLK=32,QB=QBLK*NW,KVBLK=64;
constexpr int ATTN_PITCH=DM, ATTN_UNIT_ROWS=QB;
__device__ __forceinline__ int crow(int r,int hi){return (r&3)+8*(r>>2)+4*hi;}
#define SBAR() __builtin_amdgcn_sched_barrier(0)
__device__ __forceinline__ void cmask(f32x16&p0,f32x16&p1,int jb,int qrel,int hi){
  const float NEG=-INFINITY; int kb=64*jb+4*hi;
  #pragma unroll
  for(int r=0;r<16;++r){int kv=kb+(r&3)+8*(r>>2); if(kv>qrel)p0[r]=NEG; if(kv+32>qrel)p1[r]=NEG;}
}

constexpr int NSLOT=3, SLOTB=8192;
constexpr int LDS_K=0, LDS_V=NSLOT*SLOTB, LDS_WS=2*NSLOT*SLOTB, LDS_OST=LDS_WS+NW*64*4, LDS_BYTES=LDS_OST+NW*4096;
constexpr float C2=0.125f*1.4426950408889634f;
__device__ __forceinline__ void glds16(const void*gsrc,unsigned lds_dst){unsigned keep;
  asm volatile("s_mov_b32 %0, m0\n\ts_mov_b32 m0, %2\n\ts_nop 0\n\tglobal_load_lds_dwordx4 %1, off\n\ts_mov_b32 m0, %0":"=&s"(keep):"v"(gsrc),"s"(lds_dst):"memory");}
__device__ __forceinline__ float max3f(float a,float b,float c){float r;asm("v_max3_f32 %0, %1, %2, %3":"=v"(r):"v"(a),"v"(b),"v"(c));return r;}
__device__ __forceinline__ float max2f(float a,float b){float r;asm("v_max_f32_e32 %0, %1, %2":"=v"(r):"v"(a),"v"(b));return r;}
__device__ __forceinline__ float fadd_s(float a,float b){float r;asm("v_add_f32_e32 %0, %1, %2":"=v"(r):"v"(a),"v"(b));return r;}
__device__ __forceinline__ float fsub_s(float a,float b){float r;asm("v_sub_f32_e32 %0, %1, %2":"=v"(r):"v"(a),"v"(b));return r;}
typedef float f32x2_t __attribute__((ext_vector_type(2))); typedef __bf16 bf16x2_t __attribute__((ext_vector_type(2)));
__device__ __forceinline__ unsigned cvtpk_s(float lo,float hi){f32x2_t v={lo,hi};bf16x2_t b=__builtin_convertvector(v,bf16x2_t);return __builtin_bit_cast(unsigned,b);}
#define WAIT_BAR(N) asm volatile("s_waitcnt vmcnt(" #N ") lgkmcnt(0)\n\ts_barrier":::"memory")

__device__ __forceinline__ void qkt(f32x16&p0,f32x16&p1,const char*Kslot,const bf16x8*qr,const f32x16&negm,int r32,int hi){
  const char*kb=Kslot+hi*1024+r32*16;
  #pragma unroll
  for(int d0=0;d0<4;++d0){
    const bf16x8 b0=*reinterpret_cast<const bf16x8*>(kb+d0*2048);
    const bf16x8 b1=*reinterpret_cast<const bf16x8*>(kb+d0*2048+512);
    if(d0==0){p0=__builtin_amdgcn_mfma_f32_32x32x16_bf16(b0,qr[0],negm,0,0,0);p1=__builtin_amdgcn_mfma_f32_32x32x16_bf16(b1,qr[0],negm,0,0,0);}
    else{p0=__builtin_amdgcn_mfma_f32_32x32x16_bf16(b0,qr[d0],p0,0,0,0);p1=__builtin_amdgcn_mfma_f32_32x32x16_bf16(b1,qr[d0],p1,0,0,0);}}
}
typedef __attribute__((address_space(3))) const char* lds_cptr;
typedef short v4i16_t __attribute__((ext_vector_type(4)));
__device__ __forceinline__ void kload8(bf16x8*kf,lds_cptr kp){
  kf[0]=*(const __attribute__((address_space(3))) bf16x8*)(kp);      kf[1]=*(const __attribute__((address_space(3))) bf16x8*)(kp+512);
  kf[2]=*(const __attribute__((address_space(3))) bf16x8*)(kp+2048); kf[3]=*(const __attribute__((address_space(3))) bf16x8*)(kp+2560);
  kf[4]=*(const __attribute__((address_space(3))) bf16x8*)(kp+4096); kf[5]=*(const __attribute__((address_space(3))) bf16x8*)(kp+4608);
  kf[6]=*(const __attribute__((address_space(3))) bf16x8*)(kp+6144); kf[7]=*(const __attribute__((address_space(3))) bf16x8*)(kp+6656);
}
__device__ __forceinline__ void kload2(bf16x8*kf,lds_cptr kp,int j){ kf[2*j]=*(const __attribute__((address_space(3))) bf16x8*)(kp+j*2048); kf[2*j+1]=*(const __attribute__((address_space(3))) bf16x8*)(kp+j*2048+512); }
__device__ __forceinline__ s16x4 vtr(lds_cptr p){ return __builtin_bit_cast(s16x4,__builtin_amdgcn_ds_read_tr16_b64_v4i16((__attribute__((address_space(3))) v4i16_t*)p)); }
__device__ __forceinline__ float rowmax(const f32x16&p0,const f32x16&p1){
  float a=max3f(p0[0],p0[1],p1[0]),b=max3f(p0[2],p0[3],p1[1]);a=max3f(a,p1[2],p1[3]);
  #pragma unroll
  for(int r=4;r<16;r+=4){a=max3f(a,p0[r],p0[r+1]);b=max3f(b,p0[r+2],p0[r+3]);a=max3f(a,p1[r],p1[r+1]);b=max3f(b,p1[r+2],p1[r+3]);}
  const float m=max2f(a,b);
  auto rr=__builtin_amdgcn_permlane32_swap(__float_as_uint(m),__float_as_uint(m),false,false);
  return max2f(__uint_as_float(rr[0]),__uint_as_float(rr[1]));
}
__device__ __forceinline__ void pv(f32x16*o,int vb,bf16x8 pa0,bf16x8 pa1,bf16x8 pa2,bf16x8 pa3){
  #pragma unroll
  for(int d0=0;d0<2;++d0){s16x4 lo[4],hi[4];
    #pragma unroll
    for(int ks=0;ks<4;++ks){
      asm volatile("ds_read_b64_tr_b16 %0,%1 offset:%c2":"=&v"(lo[ks]):"v"(vb),"i"(d0*4096+ks*1024):"memory");
      asm volatile("ds_read_b64_tr_b16 %0,%1 offset:%c2":"=&v"(hi[ks]):"v"(vb),"i"(d0*4096+ks*1024+512):"memory");}
    asm volatile("s_waitcnt lgkmcnt(0)":::"memory");SBAR();
    #define PK(k) (bf16x8){lo[k][0],lo[k][1],lo[k][2],lo[k][3],hi[k][0],hi[k][1],hi[k][2],hi[k][3]}
    o[d0]=__builtin_amdgcn_mfma_f32_32x32x16_bf16(pa0,PK(0),o[d0],0,0,0);
    o[d0]=__builtin_amdgcn_mfma_f32_32x32x16_bf16(pa1,PK(1),o[d0],0,0,0);
    o[d0]=__builtin_amdgcn_mfma_f32_32x32x16_bf16(pa2,PK(2),o[d0],0,0,0);
    o[d0]=__builtin_amdgcn_mfma_f32_32x32x16_bf16(pa3,PK(3),o[d0],0,0,0);
    #undef PK
  }
}

#ifndef ATTN_STORE16
#define ATTN_STORE16(p,v) (*(u32x4*)(p)=(v))
#endif
template<int THRL> __device__ __forceinline__ void attn_unit(const bf16*Qb,const bf16*__restrict__ Kh,const bf16*__restrict__ Vh,bf16*Ob,const int NT,const int NTX,const long xr0,const long cr0,char*shm){
  int tid_=threadIdx.x; asm volatile("":"+v"(tid_)); const int tid=tid_,lane=tid&63,r32=lane&31,hi=lane>>5; const int wid=__builtin_amdgcn_readfirstlane(tid>>6);
  const bf16*Qw=Qb+(long)(wid*QBLK)*DM;
  const unsigned lds0=(unsigned)(uintptr_t)shm;
  float*wsf=(float*)(shm+LDS_WS)+wid*64;
  const bf16*ksrc=Kh+(long)lane*KVP+wid*8;
  const bf16*vsrc=Vh+(long)(16*(wid&3)+(lane>>2))*KVP+(wid>>2)*32+(lane&3)*8;
  const unsigned kdst=lds0+LDS_K+wid*1024, vdst=lds0+LDS_V+wid*1024;
  #define KVROW(t) (((t)<NTX)?(xr0+(long)(t)*KVBLK):(cr0+(long)((t)-NTX)*KVBLK))
  #define DMA_K(t,slot) glds16(ksrc+KVROW(t)*KVP,(unsigned)__builtin_amdgcn_readfirstlane(kdst+(slot)))
  #define DMA_V(t,slot) glds16(vsrc+KVROW(t)*KVP,(unsigned)__builtin_amdgcn_readfirstlane(vdst+(slot)))
  const int vb0=(int)(lds0+LDS_V)+((lane>>4)&1)*32+(lane&3)*8+(4*hi+((lane&15)>>2))*64;
  const char*Kbase=shm+LDS_K; bf16x8 kf[8];
  const lds_cptr shm3=(lds_cptr)shm; const lds_cptr kp0=shm3+LDS_K+hi*1024+r32*16; const lds_cptr vp0=shm3+LDS_V+((lane>>4)&1)*32+(lane&3)*8+(4*hi+((lane&15)>>2))*64;
  DMA_K(0,0);DMA_V(0,0);DMA_K(1,SLOTB);
  bf16x8 qr[4];
  #pragma unroll
  for(int d0=0;d0<4;++d0)qr[d0]=*reinterpret_cast<const bf16x8*>(&Qw[(long)r32*DM+d0*16+hi*8]);
  float mhat=0.f,l_reg=0.f;f32x16 o[2];o[0]=f32x16{};o[1]=f32x16{};f32x16 negm=f32x16{};asm volatile("":"+v"(negm));
  #define CMASK(P0,P1,t) do{}while(0)
  bool resc=false;
  #define START(P0,P1) do{ const float rm=rowmax(P0,P1); resc=false; \
    { const float dl=rm; mhat=fadd_s(mhat,dl); \
      _Pragma("unroll") for(int r=0;r<16;++r){P0[r]=fsub_s(P0[r],dl);P1[r]=fsub_s(P1[r],dl);} \
      _Pragma("unroll") for(int r=0;r<16;++r)negm[r]=-mhat; asm volatile("":"+v"(negm)); } \
    _Pragma("unroll") for(int r=0;r<16;++r)P0[r]=__builtin_amdgcn_exp2f(P0[r]); }while(0)
  #define RESC() do{ if(resc){ asm volatile("s_waitcnt lgkmcnt(0)":::"memory"); \
      _Pragma("unroll") for(int d_=0;d_<2;++d_) _Pragma("unroll") for(int r=0;r<16;++r)o[d_][r]*=wsf[crow(r,hi)]; } }while(0)
  f32x16 pA0,pA1,pB0,pB1;
  int sl_prev=0,sl_cur=0,sl_next=SLOTB;
  #define ROT() do{sl_prev=sl_cur;sl_cur=sl_next;sl_next=(sl_next==(NSLOT-1)*SLOTB)?0:sl_next+SLOTB;}while(0)
  DMA_K(2,2*SLOTB);
  WAIT_BAR(3);
  qkt(pA0,pA1,Kbase,qr,negm,r32,hi);asm volatile("s_nop 15\n\ts_nop 7":"+v"(pA0),"+v"(pA1));CMASK(pA0,pA1,0);
  START(pA0,pA1);
  _Pragma("unroll") for(int r=0;r<16;++r)pA1[r]=__builtin_amdgcn_exp2f(pA1[r]);
  WAIT_BAR(0);
  DMA_K(3,0);DMA_V(1,SLOTB);
  ROT();
  kload8(kf,kp0+sl_cur);
  WAIT_BAR(2);
  s16x4 vlo[8],vhi[8]; u32x4 pw0,pw1,pw2,pw3;
  #define PKW(P,B) cvtpk_s(P[B],P[B+1])
  #define PAF(k) __builtin_bit_cast(bf16x8,pw##k)
  #define VFR(i) (bf16x8){vlo[i][0],vlo[i][1],vlo[i][2],vlo[i][3],vhi[i][0],vhi[i][1],vhi[i][2],vhi[i][3]}
  #define PIN(x) asm volatile("":"+v"(x))
  #define MX3(a,b,c) __builtin_fmaxf(__builtin_fmaxf((a),(b)),(c))
  #define GAPA(MF,A0,A1,A2,A3,W0,W1,PW) do{ MF; sacc+=A0; sacc+=A1; sacc+=A2; sacc+=A3; PIN(sacc); W0; W1; PIN(PW); SBAR(); }while(0)
  #define EX(v) __builtin_amdgcn_exp2f(v)
  #define GAPB(MF,X,B) do{ MF; X[B]=EX(X[B]); X[B+1]=EX(X[B+1]); X[B+2]=EX(X[B+2]); X[B+3]=EX(X[B+3]); PIN(X); SBAR(); }while(0)
  #define VRD(i) do{ vlo[i]=vtr(vp_+(((i)>>2)*4096+((i)&3)*1024)); vhi[i]=vtr(vp_+(((i)>>2)*4096+((i)&3)*1024+512)); }while(0)
  #define KRD(G,j) do{ if(G){ kload2(kf,kp0+sl_next,j); SBAR(); } }while(0)
  #define STEP(C0,C1,P0,P1,t,GK,GV,GL) do{ SBAR(); \
    const lds_cptr vp_=vp0+sl_prev; \
    VRD(0); SBAR(); float sacc=(P0[0]+P0[1]); \
    GAPA(C0=__builtin_amdgcn_mfma_f32_32x32x16_bf16(kf[0],qr[0],negm,0,0,0), P0[2],P0[3],P0[4],P0[5],     pw0[0]=PKW(P0,0), pw0[1]=PKW(P0,2), pw0); \
    VRD(4); SBAR(); GAPA(C1=__builtin_amdgcn_mfma_f32_32x32x16_bf16(kf[1],qr[0],negm,0,0,0), P0[6],P0[7],P0[8],P0[9],     pw0[2]=PKW(P0,4), pw0[3]=PKW(P0,6), pw0); \
    VRD(1); SBAR(); GAPA(C0=__builtin_amdgcn_mfma_f32_32x32x16_bf16(kf[2],qr[1],C0,0,0,0),   P0[10],P0[11],P0[12],P0[13], pw1[0]=PKW(P0,8), pw1[1]=PKW(P0,10), pw1); \
    VRD(5); SBAR(); GAPA(C1=__builtin_amdgcn_mfma_f32_32x32x16_bf16(kf[3],qr[1],C1,0,0,0),   P0[14],P0[15],P1[0],P1[1],   pw1[2]=PKW(P0,12),pw1[3]=PKW(P0,14), pw1); \
    VRD(2); SBAR(); GAPA(C0=__builtin_amdgcn_mfma_f32_32x32x16_bf16(kf[4],qr[2],C0,0,0,0),   P1[2],P1[3],P1[4],P1[5],     pw2[0]=PKW(P1,0), pw2[1]=PKW(P1,2), pw2); \
    VRD(6); SBAR(); GAPA(C1=__builtin_amdgcn_mfma_f32_32x32x16_bf16(kf[5],qr[2],C1,0,0,0),   P1[6],P1[7],P1[8],P1[9],     pw2[2]=PKW(P1,4), pw2[3]=PKW(P1,6), pw2); \
    VRD(3); SBAR(); GAPA(C0=__builtin_amdgcn_mfma_f32_32x32x16_bf16(kf[6],qr[3],C0,0,0,0),   P1[10],P1[11],P1[12],P1[13], pw3[0]=PKW(P1,8), pw3[1]=PKW(P1,10), pw3); \
    VRD(7); SBAR(); GAPA(C1=__builtin_amdgcn_mfma_f32_32x32x16_bf16(kf[7],qr[3],C1,0,0,0),   P1[14],P1[15],0.f,0.f,       pw3[2]=PKW(P1,12),pw3[3]=PKW(P1,14), pw3); \
    l_reg+=sacc; \
    if(GK){DMA_K((t)+3,sl_cur);} if(GV){DMA_V((t)+1,sl_next);} \
    CMASK(C0,C1,t); \
    { float a=MX3(C0[0],C0[1],C1[0]),b=MX3(C0[2],C0[3],C1[1]); a=MX3(a,C1[2],C1[3]); \
      _Pragma("unroll") for(int r=4;r<16;r+=4){a=MX3(a,C0[r],C0[r+1]);b=MX3(b,C0[r+2],C0[r+3]);a=MX3(a,C1[r],C1[r+1]);b=MX3(b,C1[r+2],C1[r+3]);} \
      float rm=__builtin_fmaxf(a,b); { auto rr=__builtin_amdgcn_permlane32_swap(__float_as_uint(rm),__float_as_uint(rm),false,false); rm=__builtin_fmaxf(__uint_as_float(rr[0]),__uint_as_float(rr[1])); } \
      resc=false; \
      if(__builtin_expect(__any(rm>(float)THRL),0)){ const float dl=__builtin_fmaxf(rm,0.f); mhat+=dl; \
        _Pragma("unroll") for(int r=0;r<16;++r){C0[r]-=dl;C1[r]-=dl;} \
        _Pragma("unroll") for(int r=0;r<16;++r)negm[r]=-mhat; asm volatile("":"+v"(negm)); \
        const float f=__builtin_amdgcn_exp2f(-dl); l_reg*=f; if(hi==0)wsf[r32]=f; resc=true; } } \
    SBAR(); \
    GAPB(o[0]=__builtin_amdgcn_mfma_f32_32x32x16_bf16(PAF(0),VFR(0),o[0],0,0,0), C0,0); \
    GAPB(o[1]=__builtin_amdgcn_mfma_f32_32x32x16_bf16(PAF(0),VFR(4),o[1],0,0,0), C0,4); \
    KRD(GL,0); GAPB(o[0]=__builtin_amdgcn_mfma_f32_32x32x16_bf16(PAF(1),VFR(1),o[0],0,0,0), C0,8); \
    KRD(GL,1); GAPB(o[1]=__builtin_amdgcn_mfma_f32_32x32x16_bf16(PAF(1),VFR(5),o[1],0,0,0), C0,12); \
    KRD(GL,2); GAPB(o[0]=__builtin_amdgcn_mfma_f32_32x32x16_bf16(PAF(2),VFR(2),o[0],0,0,0), C1,0); \
    KRD(GL,3); GAPB(o[1]=__builtin_amdgcn_mfma_f32_32x32x16_bf16(PAF(2),VFR(6),o[1],0,0,0), C1,4); \
    GAPB(o[0]=__builtin_amdgcn_mfma_f32_32x32x16_bf16(PAF(3),VFR(3),o[0],0,0,0), C1,8); \
    GAPB(o[1]=__builtin_amdgcn_mfma_f32_32x32x16_bf16(PAF(3),VFR(7),o[1],0,0,0), C1,12); \
    }while(0)
  int t=1;
  #undef CMASK
  #define CMASK(P0,P1,t) do{}while(0)
  for(;t+5<NT;t+=2){
    STEP(pB0,pB1,pA0,pA1,t,true,true,true);     WAIT_BAR(2); RESC(); ROT();
    STEP(pA0,pA1,pB0,pB1,t+1,true,true,true);   WAIT_BAR(2); RESC(); ROT();
  }
  #undef CMASK
  #define CMASK(P0,P1,t) do{}while(0)
  #define ENDW(tt) do{ if((tt)+3<NT){WAIT_BAR(2);} else if((tt)+2<NT){WAIT_BAR(1);} else {WAIT_BAR(0);} }while(0)
  for(;t+1<NT;t+=2){
    STEP(pB0,pB1,pA0,pA1,t,(t+3<NT),(t+1<NT),(t+1<NT));       ENDW(t);   RESC(); ROT();
    STEP(pA0,pA1,pB0,pB1,t+1,(t+4<NT),(t+2<NT),(t+2<NT));     ENDW(t+1); RESC(); ROT();
  }
  STEP(pB0,pB1,pA0,pA1,NT-1,false,false,false); RESC();
  { float sacc=pB0[0]+pB0[1]; _Pragma("unroll") for(int r=2;r<16;++r)sacc+=pB0[r]; _Pragma("unroll") for(int r=0;r<16;++r)sacc+=pB1[r]; l_reg+=sacc;
    pw0=(u32x4){PKW(pB0,0),PKW(pB0,2),PKW(pB0,4),PKW(pB0,6)};pw1=(u32x4){PKW(pB0,8),PKW(pB0,10),PKW(pB0,12),PKW(pB0,14)};pw2=(u32x4){PKW(pB1,0),PKW(pB1,2),PKW(pB1,4),PKW(pB1,6)};pw3=(u32x4){PKW(pB1,8),PKW(pB1,10),PKW(pB1,12),PKW(pB1,14)};
    SBAR(); pv(o,vb0+sl_cur,PAF(0),PAF(1),PAF(2),PAF(3)); }
  #undef PKW
  #undef PAF
  #undef VFR
  #undef PIN
  #undef MX3
  #undef GAPA
  #undef GAPB
  #undef EX
  #undef VRD
  #undef KRD
  #undef STEP
  #undef ENDW
  {auto rr=__builtin_amdgcn_permlane32_swap(__float_as_uint(l_reg),__float_as_uint(l_reg),false,false);l_reg=__uint_as_float(rr[0])+__uint_as_float(rr[1]);}
  if(hi==0)wsf[32+r32]=l_reg;asm volatile("s_waitcnt lgkmcnt(0)":::"memory");
  float rli[16];
  #pragma unroll
  for(int r=0;r<16;++r)rli[r]=__builtin_amdgcn_rcpf(wsf[32+crow(r,hi)]);
  bf16*Ow=Ob+(long)(wid*QBLK)*DM;
  { bf16*stg=(bf16*)(shm+LDS_OST)+wid*2048;
    #pragma unroll
    for(int r=0;r<16;++r){const int orow=crow(r,hi);
      #pragma unroll
      for(int d0=0;d0<2;++d0)stg[orow*64+d0*32+r32]=__float2bfloat16(o[d0][r]*rli[r]);}
    asm volatile("s_waitcnt lgkmcnt(0)":::"memory");
    #pragma unroll
    for(int i=0;i<4;++i){const int row=i*8+(lane>>3),ch=lane&7; const u32x4 v=*(const u32x4*)(stg+row*64+ch*8); ATTN_STORE16(Ow+(long)row*DM+ch*8,v);} }
  asm volatile("s_waitcnt lgkmcnt(0)\n\ts_barrier":::"memory");
  #undef DMA_K
  #undef KVROW
  #undef DMA_V
  #undef CMASK
  #undef START
  #undef RESC
  #undef ROT
}
#undef SBAR
#undef WAIT_BAR
}
#ifndef REP
#define REP 0
#endif
#ifndef DIS
#define DIS 0
#endif
namespace cg = cooperative_groups;
#define LAS __attribute__((address_space(3)))
typedef unsigned short bf16;
typedef unsigned v4u __attribute__((ext_vector_type(4)));
typedef unsigned v2u __attribute__((ext_vector_type(2)));
typedef float f32x4 __attribute__((ext_vector_type(4)));
typedef float f32x2 __attribute__((ext_vector_type(2)));
typedef unsigned short bf16_;
#define RLX_AGENT __ATOMIC_RELAXED, __HIP_MEMORY_SCOPE_AGENT
#define LDS_WAIT() asm volatile("s_waitcnt lgkmcnt(0)" ::: "memory")
#define VM_WAIT() asm volatile("s_waitcnt vmcnt(0)" ::: "memory")
#define XB_TMO      128
#define XB_XCNT(j)  (256  + 64 * (j))
#define XB_XSUB(j)  (1280 + 64 * (j))
#define XB_XGEN(j)  (2304 + 64 * (j))
#define XB_TOP      3328
#define XB_TOPGEN   3392
#define XCD_BAR_WORDS 3456
#define XB_SPIN_CAP (1u << 18)

__device__ __forceinline__ unsigned xb_ld(unsigned* p)              { return __hip_atomic_load(p, __ATOMIC_RELAXED, __HIP_MEMORY_SCOPE_AGENT); }
__device__ __forceinline__ unsigned xb_add(unsigned* p, unsigned v) { return __hip_atomic_fetch_add(p, v, __ATOMIC_RELAXED, __HIP_MEMORY_SCOPE_AGENT); }
__device__ __forceinline__ unsigned xb_xcc_id() { return (unsigned)__builtin_amdgcn_s_getreg((3 << 11) | 20) & 0xFu; }
#define XB_SPIN(cond, bar) do { unsigned _sp = 0; while (cond) { __builtin_amdgcn_s_sleep(1); \
    if ((++_sp & 255u) == 0u) { if (xb_ld(&(bar)[XB_TMO])) break; if (_sp > XB_SPIN_CAP) { atomicAdd(&(bar)[XB_TMO], 1u); break; } } } } while (0)

struct XcdBarrier {
    unsigned* bar; unsigned x;
    volatile LAS unsigned* st;
};

__device__ __forceinline__ XcdBarrier xcd_barrier_post(unsigned* bar, volatile LAS unsigned* st) {
    XcdBarrier b; b.bar = bar; b.x = xb_xcc_id(); b.st = st;
    if (threadIdx.x == 0) (void)xb_add(&bar[XB_XCNT(b.x)], 1u);
    return b;
}
__device__ __forceinline__ void xcd_barrier_complete(unsigned* bar, unsigned x, unsigned& nloc, unsigned& nx) {
    const unsigned G = gridDim.x * gridDim.y * gridDim.z;
    unsigned sum, cnt, mine, sp = 0u;
    for (;;) {
        sum = 0u; cnt = 0u; mine = 0u;
#pragma unroll
        for (unsigned j = 0; j < 16; ++j) { const unsigned c = xb_ld(&bar[XB_XCNT(j)]); sum += c; cnt += (c > 0u) ? 1u : 0u; mine = (j == x) ? c : mine; }
        if (sum == G) break;
        __builtin_amdgcn_s_sleep(1);
        if ((++sp & 255u) == 0u) { if (xb_ld(&bar[XB_TMO])) break; if (sp > XB_SPIN_CAP) { atomicAdd(&bar[XB_TMO], 1u); break; } }
    }
    nloc = mine > 0u ? mine : 1u; nx = cnt > 0u ? cnt : 1u;
}

__device__ __forceinline__ void xcd_barrier(const XcdBarrier& b) {
    asm volatile("s_waitcnt vmcnt(0)" ::: "memory");
    __syncthreads();
    if (threadIdx.x == 0) {
        unsigned* bar = b.bar;
        __builtin_amdgcn_s_waitcnt(0);
        unsigned nloc = b.st[0], nx = b.st[1];
        if (nloc == 0u) { xcd_barrier_complete(bar, b.x, nloc, nx); b.st[0] = nloc; b.st[1] = nx; }
        const unsigned old = xb_add(&bar[XB_XSUB(b.x)], 1u);
        const unsigned gen = old / nloc;
        if (old + 1u == (gen + 1u) * nloc) {
            __builtin_amdgcn_fence(__ATOMIC_RELEASE, "agent");
            asm volatile("s_waitcnt vmcnt(0)" ::: "memory");
            const unsigned og = xb_add(&bar[XB_TOP], 1u);
            const unsigned tg = og / nx;
            if (og + 1u == (tg + 1u) * nx) xb_add(&bar[XB_TOPGEN], 1u);
            else XB_SPIN(xb_ld(&bar[XB_TOPGEN]) == tg, bar);
            __builtin_amdgcn_fence(__ATOMIC_ACQUIRE, "agent");
            xb_add(&bar[XB_XGEN(b.x)], 1u);
            asm volatile("s_waitcnt vmcnt(0)" ::: "memory");
        } else {
            XB_SPIN(xb_ld(&bar[XB_XGEN(b.x)]) == gen, bar);
            __builtin_amdgcn_fence(__ATOMIC_ACQUIRE, "agent");
            asm volatile("s_waitcnt vmcnt(0)" ::: "memory");
        }
    }
    __syncthreads();
}
constexpr int NWAVES = 8;
constexpr int DM = 1024, NBATCH = 8, SEQ = 2048, CTXL = 256, MX = NBATCH * SEQ, MC = NBATCH * CTXL, MT = MX + MC;
constexpr int DFF = 2816, DEPTH = 4, NMODV = 6, MODW = NMODV * DM;
constexpr float EPS = 1e-6f;
constexpr size_t MiB = 1u << 20;
constexpr size_t WS_CTL = 0, WS_MOD = 1 * MiB, WS_ROPE = 2 * MiB, WS_SSQ = 3 * MiB, WS_PW1T = 5 * MiB, WS_PW2T = 13 * MiB, WS_QKVT = 17 * MiB, WS_WOT = 23 * MiB, WS_W13T = 27 * MiB, WS_W2T = 71 * MiB,
                 WS_X = 93 * MiB, WS_Y = 165 * MiB, WS_H = 237 * MiB, WS_G = 273 * MiB, WS_END = 372 * MiB;
constexpr size_t WS_U = WS_G, WS_CV = WS_G + 36 * MiB, WS_KB = WS_G + 36 * MiB, WS_VB = WS_G + 45 * MiB, WS_O = WS_G + 54 * MiB;
constexpr int RING_BYTES = 131072, LDS_BYTES = 147456, MISC_OFF = RING_BYTES + 320;
constexpr int CW_BAR = 4096;
constexpr int N_PHASES = 2 + 7 * DEPTH;

__device__ __forceinline__ unsigned f2bf(float f) { unsigned u = __builtin_bit_cast(unsigned, f); return (u + 0x7fffu + ((u >> 16) & 1u)) >> 16; }
__device__ __forceinline__ unsigned pk2(float lo, float hi) { return f2bf(lo) | (f2bf(hi) << 16); }
__device__ __forceinline__ float wave_sum(float v) {
#pragma unroll
    for (int o = 1; o < 64; o <<= 1) v += __shfl_xor(v, o);
    return v;
}
struct Args { const float* in[24]; float* out; unsigned char* ws; int ph_lo, ph_hi; };
struct Frame {
    LAS unsigned char* lds;
    int tid, lane, wave, vcu, G;
    float* out; unsigned char* ws;
};
__device__ __forceinline__ void transpose_item(const float* W, int N, bf16* WT, int KT, int dst_row0, LAS float* scr, int k0, int n0, int lane) {
#pragma unroll 8
    for (int i = 0; i < 32; ++i) { const int kk = 2 * i + (lane >> 5); scr[kk * 33 + (lane & 31)] = W[(size_t)(k0 + kk) * N + n0 + (lane & 31)]; }
    asm volatile("s_waitcnt lgkmcnt(0)" ::: "memory");
    const int c = lane & 7;
#pragma unroll
    for (int j = 0; j < 4; ++j) { const int n = (lane >> 3) + 8 * j; const LAS float* s = scr + (8 * c) * 33 + n;
        v4u o; o.x = pk2(s[0 * 33], s[1 * 33]); o.y = pk2(s[2 * 33], s[3 * 33]); o.z = pk2(s[4 * 33], s[5 * 33]); o.w = pk2(s[6 * 33], s[7 * 33]);
        *(v4u*)(WT + (size_t)(dst_row0 + n) * KT + k0 + 8 * c) = o; }
    asm volatile("s_waitcnt lgkmcnt(0)" ::: "memory");
}
__device__ __forceinline__ int map_row(int kind, int n0) {
    if (kind == 0) return n0;
    if (kind == 1) { const int bj = n0 >> 10, rem = n0 & 1023; return 256 * (rem >> 7) + 128 * bj + (rem & 127); }
    if (kind == 2) return 256 * (n0 >> 7) + (n0 & 127);
    if (kind == 3) return 256 * (n0 >> 7) + 128 + (n0 & 127);
    const int head = n0 >> 6, bj = (n0 >> 5) & 1;
    if (kind == 4) return 256 * (head >> 2) + 128 * bj + 32 * (head & 3);
    if (kind == 5) return 1024 + 128 * bj + 32 * head;
    return 1280 + 128 * bj + 32 * head;
}
__device__ __forceinline__ void p0_prologue(Frame& F, const Args& args) {
    LAS float* scr = (LAS float*)(F.lds + F.wave * 16384);
    const int gw = F.vcu * NWAVES + F.wave, NGW = F.G * NWAVES;
    unsigned char* ws = F.ws;
    constexpr int I_PW1 = 16 * 64, I_SQ = 16 * 32, I_KV = 16 * 8, I_W1 = 16 * 88, I_W2 = 44 * 32;
    constexpr int I_CONV = I_PW1 + I_SQ, I_ATT = 2 * I_SQ + 2 * I_KV, I_FFN = 2 * I_W1 + I_W2;
    constexpr int NITEMS = 2 * I_CONV + 2 * I_ATT + 4 * I_FFN;
    for (int it = gw; it < NITEMS; it += NGW) {
        int r = it; const float* W; int K, N, kind; bf16* WT;
        if (r < 2 * I_CONV) { const int j = r / I_CONV; r -= j * I_CONV;
            if (r < I_PW1) { W = args.in[7] + (size_t)j * DM * 2 * DM; K = DM; N = 2 * DM; kind = 1; WT = (bf16*)(ws + WS_PW1T) + (size_t)j * 2 * DM * DM; }
            else { r -= I_PW1; W = args.in[13] + (size_t)j * DM * DM; K = DM; N = DM; kind = 0; WT = (bf16*)(ws + WS_PW2T) + (size_t)j * DM * DM; } }
        else if (r < 2 * I_CONV + 2 * I_ATT) { r -= 2 * I_CONV; const int j = r / I_ATT; r -= j * I_ATT; K = DM;
            bf16* qkv = (bf16*)(ws + WS_QKVT) + (size_t)j * 1536 * DM;
            if (r < I_SQ) { W = args.in[15] + (size_t)j * DM * DM; N = DM; kind = 4; WT = qkv; }
            else if (r < I_SQ + I_KV) { r -= I_SQ; W = args.in[16] + (size_t)j * DM * 256; N = 256; kind = 5; WT = qkv; }
            else if (r < I_SQ + 2 * I_KV) { r -= I_SQ + I_KV; W = args.in[17] + (size_t)j * DM * 256; N = 256; kind = 6; WT = qkv; }
            else { r -= I_SQ + 2 * I_KV; W = args.in[18] + (size_t)j * DM * DM; N = DM; kind = 0; WT = (bf16*)(ws + WS_WOT) + (size_t)j * DM * DM; } }
        else { r -= 2 * I_CONV + 2 * I_ATT; const int i = r / I_FFN; r -= i * I_FFN;
            bf16* w13 = (bf16*)(ws + WS_W13T) + (size_t)i * 2 * DFF * DM;
            if (r < I_W1) { W = args.in[21] + (size_t)i * DM * DFF; K = DM; N = DFF; kind = 2; WT = w13; }
            else if (r < 2 * I_W1) { r -= I_W1; W = args.in[22] + (size_t)i * DM * DFF; K = DM; N = DFF; kind = 3; WT = w13; }
            else { r -= 2 * I_W1; W = args.in[23] + (size_t)i * DFF * DM; K = DFF; N = DM; kind = 0; WT = (bf16*)(ws + WS_W2T) + (size_t)i * DM * DFF; } }
        const int nblk = N / 32, kb = r / nblk, nb = r % nblk;
        transpose_item(W, N, WT, K, map_row(kind, 32 * nb), scr, 64 * kb, 32 * nb, F.lane);
    }
    __syncthreads();
    if (blockIdx.x == 0) { float* tab = (float*)(ws + WS_ROPE);
        for (int idx = F.tid; idx < 64 * 16; idx += NWAVES * 64) { const int pos = idx >> 4, j = idx & 15; const float fr = powf(10000.0f, -(float)j * (1.0f / 16.0f)); const float ang = (float)pos * fr;
            tab[2 * idx] = cosf(ang); tab[2 * idx + 1] = sinf(ang); } }
    LAS float* sc = (LAS float*)F.lds;
    LAS float* red = sc + 9 * 1024;
    for (int idx = F.tid; idx < 9 * 1024; idx += NWAVES * 64) { const int mr = idx >> 10, k = idx & 1023; const float v = mr < 8 ? args.in[1][mr * DM + k] : args.in[3][k]; sc[idx] = v / (1.0f + __expf(-v)); }
    __syncthreads();
    float* mod = (float*)(ws + WS_MOD);
    for (int item = F.vcu; item < DEPTH * 48; item += F.G) {
        const int i = item / 48, cgp = item % 48;
        const float* W = args.in[4] + (size_t)i * DM * MODW + cgp * 128 + 2 * F.lane;
        float a0[9], a1[9];
#pragma unroll
        for (int mr = 0; mr < 9; ++mr) { a0[mr] = 0.f; a1[mr] = 0.f; }
        const int k0 = F.wave * 128;
#pragma unroll 8
        for (int kk = 0; kk < 128; ++kk) { const f32x2 w = *(const f32x2*)(W + (size_t)(k0 + kk) * MODW);
#pragma unroll
            for (int mr = 0; mr < 9; ++mr) { const float s = sc[mr * 1024 + k0 + kk]; a0[mr] += s * w.x; a1[mr] += s * w.y; } }
#pragma unroll
        for (int mr = 0; mr < 9; ++mr) { red[(F.wave * 9 + mr) * 128 + 2 * F.lane] = a0[mr]; red[(F.wave * 9 + mr) * 128 + 2 * F.lane + 1] = a1[mr]; }
        __syncthreads();
        for (int o = F.tid; o < 9 * 128; o += NWAVES * 64) { const int mr = o >> 7, col = o & 127; float s = 0.f;
#pragma unroll
            for (int w = 0; w < 8; ++w) s += red[(w * 9 + mr) * 128 + col];
            mod[(size_t)(i * 9 + mr) * MODW + cgp * 128 + col] = s + args.in[5][i * MODW + cgp * 128 + col]; }
        __syncthreads();
    }
}
struct RN { const float* xa; const float* xb; float* oa; float* ob; const float* Y; const float* P; int nparts; const float* gate; const float* gpost; const float* gpre; const float* scm; const float* shm; bf16* H; int nrows; };
__device__ __forceinline__ void resnorm_phase(Frame& F, const RN a) {
    const int gw = F.vcu * NWAVES + F.wave, NGW = F.G * NWAVES;
    const int perx = (MX + NGW - 1) / NGW, nctx = a.nrows - MX, perc = (nctx + NGW - 1) / NGW;
    const bool has_y = a.Y != nullptr, wr_x = a.oa != nullptr, wr_h = a.H != nullptr;
    int cur = -1; f32x4 A[4], Bv[4], Cv[4];
    for (int it = 0; it < perx + perc; ++it) {
        int r; if (it < perx) { r = gw * perx + it; if (r >= MX) continue; } else { const int rc = gw * perc + (it - perx); if (rc >= nctx) continue; r = MX + rc; }
        const int mr = r < MX ? (r >> 11) : 8;
        if (mr != cur) { cur = mr;
#pragma unroll
            for (int j = 0; j < 4; ++j) { const int c = 4 * F.lane + 256 * j;
                if (has_y) A[j] = *(const f32x4*)(a.gate + (size_t)mr * MODW + c) * *(const f32x4*)(a.gpost + c);
                if (wr_h) { Bv[j] = *(const f32x4*)(a.gpre + c) * (*(const f32x4*)(a.scm + (size_t)mr * MODW + c) + 1.0f); Cv[j] = *(const f32x4*)(a.shm + (size_t)mr * MODW + c); } } }
        const float* xr = r < MX ? a.xa + (size_t)r * DM : a.xb + (size_t)(r - MX) * DM;
        f32x4 xv[4];
#pragma unroll
        for (int j = 0; j < 4; ++j) xv[j] = *(const f32x4*)(xr + 4 * F.lane + 256 * j);
        if (has_y) {
            f32x4 yv[4];
            if (r < MX || a.nparts == 0) {
#pragma unroll
                for (int j = 0; j < 4; ++j) yv[j] = *(const f32x4*)(a.Y + (size_t)r * DM + 4 * F.lane + 256 * j);
            } else {
                const float* pp = a.P + (size_t)(r - MX) * DM + 4 * F.lane; f32x4 p1[4], p2[4], p3[4];
#pragma unroll
                for (int j = 0; j < 4; ++j) { yv[j] = *(const f32x4*)(pp + 256 * j); p1[j] = *(const f32x4*)(pp + (size_t)MC * DM + 256 * j); p2[j] = *(const f32x4*)(pp + (size_t)2 * MC * DM + 256 * j); p3[j] = *(const f32x4*)(pp + (size_t)3 * MC * DM + 256 * j); }
#pragma unroll
                for (int j = 0; j < 4; ++j) yv[j] = ((yv[j] + p1[j]) + p2[j]) + p3[j];
                if (a.nparts > 4) {
#pragma unroll
                    for (int j = 0; j < 4; ++j) { p1[j] = *(const f32x4*)(pp + (size_t)4 * MC * DM + 256 * j); p2[j] = *(const f32x4*)(pp + (size_t)5 * MC * DM + 256 * j); }
#pragma unroll
                    for (int j = 0; j < 4; ++j) yv[j] = (yv[j] + p1[j]) + p2[j]; }
            }
            float ss = 0.f;
#pragma unroll
            for (int j = 0; j < 4; ++j) ss += (yv[j].x * yv[j].x + yv[j].y * yv[j].y) + (yv[j].z * yv[j].z + yv[j].w * yv[j].w);
            const float inv = __builtin_amdgcn_rsqf(wave_sum(ss) * (1.0f / DM) + EPS);
#pragma unroll
            for (int j = 0; j < 4; ++j) xv[j] = xv[j] + A[j] * (yv[j] * inv);
        }
        if (wr_x) { float* xo = r < MX ? a.oa + (size_t)r * DM : a.ob + (size_t)(r - MX) * DM;
#pragma unroll
            for (int j = 0; j < 4; ++j) *(f32x4*)(xo + 4 * F.lane + 256 * j) = xv[j]; }
        if (wr_h) {
            float s2 = 0.f;
#pragma unroll
            for (int j = 0; j < 4; ++j) s2 += (xv[j].x * xv[j].x + xv[j].y * xv[j].y) + (xv[j].z * xv[j].z + xv[j].w * xv[j].w);
            const float inv2 = __builtin_amdgcn_rsqf(wave_sum(s2) * (1.0f / DM) + EPS);
#pragma unroll
            for (int j = 0; j < 4; ++j) { const f32x4 h = xv[j] * inv2 * Bv[j] + Cv[j]; v2u w; w.x = pk2(h.x, h.y); w.y = pk2(h.z, h.w); *(v2u*)(a.H + (size_t)r * DM + 4 * F.lane + 256 * j) = w; }
        }
    }
}
__device__ __forceinline__ float bf_lo(unsigned v) { return __builtin_bit_cast(float, v << 16); }
__device__ __forceinline__ float bf_hi(unsigned v) { return __builtin_bit_cast(float, v & 0xffff0000u); }
__device__ __forceinline__ void conv_phase(Frame& F, const Args& args, int jc, const bf16* U, bf16* CV) {
    const int c0 = 2 * F.tid;
    float w0[31], w1[31];
#pragma unroll
    for (int k = 0; k < 31; ++k) { const f32x2 t = *(const f32x2*)(args.in[9] + (size_t)(jc * 31 + k) * DM + c0); w0[k] = t.x; w1[k] = t.y; }
    const f32x2 bdw = *(const f32x2*)(args.in[10] + jc * DM + c0), lng = *(const f32x2*)(args.in[11] + jc * DM + c0), lnb = *(const f32x2*)(args.in[12] + jc * DM + c0);
    LAS float* red = (LAS float*)F.lds;
    for (int item = F.vcu; item < MT / 8; item += F.G) {
        const int row0 = item * 8; int s0, L; if (row0 < MX) { s0 = row0 & ~(SEQ - 1); L = SEQ; } else { s0 = MX + ((row0 - MX) & ~(CTXL - 1)); L = CTXL; }
        const int t0 = row0 - s0;
        float a0[8], a1[8];
#pragma unroll
        for (int t = 0; t < 8; ++t) { a0[t] = bdw.x; a1[t] = bdw.y; }
        const unsigned char* Ub = (const unsigned char*)(U + (size_t)s0 * DM + c0);
        unsigned uv[38];
#pragma unroll
        for (int r = 0; r < 38; ++r) { const int tt = t0 - 15 + r; const int tc = min(max(tt, 0), L - 1); uv[r] = *(const unsigned*)(Ub + (size_t)tc * (DM * 2)); }
        __builtin_amdgcn_sched_barrier(0);
#pragma unroll
        for (int r = 0; r < 38; ++r) { const int tt = t0 - 15 + r; const unsigned msk = (unsigned)(~(tt >> 31) & ((tt - L) >> 31)); const unsigned uu = uv[r] & msk; const float u0 = bf_lo(uu), u1 = bf_hi(uu);
#pragma unroll
            for (int t = 0; t < 8; ++t) { const int k = r - t; if (k >= 0 && k <= 30) { a0[t] += w0[k] * u0; a1[t] += w1[k] * u1; } } }
        float st[16];
#pragma unroll
        for (int t = 0; t < 8; ++t) { st[2 * t] = wave_sum(a0[t] + a1[t]); st[2 * t + 1] = wave_sum(a0[t] * a0[t] + a1[t] * a1[t]); }
        if (F.lane == 0) {
#pragma unroll
            for (int i = 0; i < 16; ++i) red[F.wave * 16 + i] = st[i]; }
        __syncthreads();
        if (F.tid < 16) { float s = 0.f;
#pragma unroll
            for (int w = 0; w < 8; ++w) s += red[w * 16 + F.tid];
            red[128 + F.tid] = s; }
        __syncthreads();
#pragma unroll
        for (int t = 0; t < 8; ++t) { const float mu = red[128 + 2 * t] * (1.0f / DM), var = red[128 + 2 * t + 1] * (1.0f / DM) - mu * mu; const float rstd = __builtin_amdgcn_rsqf(fmaxf(var, 0.f) + EPS);
            const float y0 = (a0[t] - mu) * rstd * lng.x + lnb.x, y1 = (a1[t] - mu) * rstd * lng.y + lnb.y;
            *(unsigned*)(CV + (size_t)(row0 + t) * DM + c0) = pk2(y0 / (1.0f + __expf(-y0)), y1 / (1.0f + __expf(-y1))); }
    }
    __syncthreads();
}

__global__ void __launch_bounds__(NWAVES * 64, 2) mk_fwd(Args args) {
    extern __shared__ __attribute__((aligned(16))) unsigned char lds[];

    for (int u = threadIdx.x; u < (LDS_BYTES - RING_BYTES) / 4; u += NWAVES * 64) ((LAS unsigned*)((LAS unsigned char*)lds + RING_BYTES))[u] = 0u;
    __syncthreads();
    const bool fused = args.ph_hi - args.ph_lo > 1;
    XcdBarrier bar; bar.bar = (unsigned*)(args.ws + WS_CTL) + CW_BAR; bar.x = 0; bar.st = nullptr;
    if (fused) bar = xcd_barrier_post((unsigned*)(args.ws + WS_CTL) + CW_BAR, (volatile LAS unsigned*)((LAS unsigned char*)lds + MISC_OFF) + 8);
    int rep_done = 0;
    for (int ph = args.ph_lo; ph < args.ph_hi; ) {
        size_t wsz_ = 0; asm volatile("" : "+s"(wsz_)); unsigned char* ws = args.ws + wsz_;
        Frame F;
        F.lds = (LAS unsigned char*)lds;
        { int t_ = threadIdx.x; asm volatile("" : "+v"(t_)); F.tid = t_; } F.lane = F.tid & 63; F.wave = __builtin_amdgcn_readfirstlane(F.tid >> 6);
        F.G = gridDim.x; { const int bx = blockIdx.x; F.vcu = (F.G % 8 == 0) ? (bx % 8) * (F.G / 8) + bx / 8 : bx; }
        F.out = args.out; F.ws = ws;
        float* const mod = (float*)(ws + WS_MOD); float* const X = (float*)(ws + WS_X); float* const Y = (float*)(ws + WS_Y);
        bf16* const H = (bf16*)(ws + WS_H); bf16* const U = (bf16*)(ws + WS_U); bf16* const CV = (bf16*)(ws + WS_CV); bf16* const KB = (bf16*)(ws + WS_KB); bf16* const VB = (bf16*)(ws + WS_VB); bf16* const GB = (bf16*)(ws + WS_G); bf16* const OB = (bf16*)(ws + WS_O);
        const float* const normg = args.in[6];
        const int rcode = ph < 2 ? 7 + ph : (((ph - 2) % 7 == 1 && (((ph - 2) / 7) & 1)) ? 9 : (ph - 2) % 7);
        {
        if (ph == 0) {
#if !(DIS & 1)
 p0_prologue(F, args);
#endif
 }
        else if (ph == 1) {
            RN a{args.in[0], args.in[2], nullptr, nullptr, nullptr, nullptr, 0, nullptr, nullptr, normg, mod + 1 * DM, mod + 0 * DM, H, MT};
            resnorm_phase(F, a);
        } else {
            const int L = (ph - 2) / 7, sub = (ph - 2) % 7; const bool conv = (L & 1) == 0, last = (L == DEPTH - 1); const int jl = L >> 1;
            const int nMrows = last ? MX / 256 : MT / 256;
            if (sub == 0) {
                if (conv) {
                    pg8::Gemm g{H, (const bf16*)(ws + WS_PW1T) + (size_t)jl * 2 * DM * DM, MT, 2 * DM, DM}; pg8::TileOrder S; S.init(MT / 256, 8, DM / 64, F.G, (int)blockIdx.x);
                    pg8::EpiGate<0> E{U, DM, args.in[8] + jl * 2 * DM};
#if !(DIS & 2)
                    pg8::gemm_phase<pg8::EpiGate<0>, pg8::TileOrder, true, true>(F.lds, g, S, E);
#endif
                } else {
                    pg8::Gemm g{H, (const bf16*)(ws + WS_QKVT) + (size_t)jl * 1536 * DM, MT, 1536, DM}; pg8::TileOrder S;
                    if (last) { S.init(MX / 256, 6, DM / 64, F.G, (int)blockIdx.x); S.extra(2 * (MC / 256), MX / 256, 4, 2, 1, DM / 64); } else S.init(MT / 256, 6, DM / 64, F.G, (int)blockIdx.x);
                    pg8::EpiQKV E{U, KB, VB, args.in[19] + jl * 64, args.in[20] + jl * 64, (const float*)(ws + WS_ROPE)};
#if !(DIS & 4)
                    pg8::gemm_phase<pg8::EpiQKV, pg8::TileOrder, true, true>(F.lds, g, S, E);
#endif
                }
            } else if (sub == 1) {
                if (conv) {
#if !(DIS & 8)
 conv_phase(F, args, jl, U, CV);
#endif
 }
                else {
                    const int nxu = NBATCH * 16 * (SEQ / 256), ncu = last ? 0 : NBATCH * 16;
                    for (int id = F.vcu; id < nxu + ncu; id += F.G) {
                        int b, h, NT, NTX; long qrow, xr0, cr0;
                        if (id < nxu) { b = id >> 7; h = (id >> 3) & 15; qrow = (long)b * SEQ + (id & 7) * 256; NT = 36; NTX = 32; xr0 = (long)b * SEQ; cr0 = MX + (long)b * CTXL; }
                        else { const int e = id - nxu; b = e >> 4; h = e & 15; qrow = MX + (long)b * CTXL; NT = 4; NTX = 0; xr0 = 0; cr0 = MX + (long)b * CTXL; }
#if !(DIS & 16)
                        attn_body::attn_unit<8>((const attn_body::bf16*)U + qrow * DM + h * 64, (const attn_body::bf16*)KB + (h >> 2) * 64, (const attn_body::bf16*)VB + (h >> 2) * 64,
                                                (attn_body::bf16*)OB + qrow * DM + h * 64, NT, NTX, xr0, cr0, (char*)lds);
#endif
                    }
                }
            } else if (sub == 2 || sub == 5) {
                pg8::Gemm g; const float* bias = nullptr;
                if (sub == 5) g = pg8::Gemm{GB, (const bf16*)(ws + WS_W2T) + (size_t)L * DM * DFF, MT, DM, DFF};
                else if (conv) { g = pg8::Gemm{CV, (const bf16*)(ws + WS_PW2T) + (size_t)jl * DM * DM, MT, DM, DM}; bias = args.in[14] + jl * DM; }
                else g = pg8::Gemm{OB, (const bf16*)(ws + WS_WOT) + (size_t)jl * DM * DM, MT, DM, DM};
                pg8::TileOrder S; S.init(MX / 256, 4, g.K / 64, F.G, (int)blockIdx.x);
                if (!last) { if (sub == 5) S.extra(4 * (MC / 256), MX / 256, 0, 4, 6, 8); else S.extra(4 * (MC / 256), MX / 256, 0, 4, 4, 4); }
                pg8::EpiY E{Y, args.out, bias, g.K / 64, sub == 5 ? 9 : 8};
#if !(DIS & 32)
                pg8::gemm_phase<pg8::EpiY, pg8::TileOrder, true, true>(F.lds, g, S, E);
#endif
            } else if (sub == 3) {
                const float* ml = mod + (size_t)L * 9 * MODW;
                RN a{L == 0 ? args.in[0] : X, L == 0 ? args.in[2] : X + (size_t)MX * DM, X, X + (size_t)MX * DM, Y, args.out, last ? 0 : 4, ml + 2 * DM, normg + (L * 4 + 1) * DM, normg + (L * 4 + 2) * DM, ml + 4 * DM, ml + 3 * DM, H, nMrows * 256};
                resnorm_phase(F, a);
            } else if (sub == 4) {
                pg8::Gemm g{H, (const bf16*)(ws + WS_W13T) + (size_t)L * 2 * DFF * DM, MT, 2 * DFF, DM}; pg8::TileOrder S; S.init(nMrows, 2 * DFF / 256, DM / 64, F.G, (int)blockIdx.x);
                pg8::EpiGate<1> E{GB, DFF, nullptr};
#if !(DIS & 64)
                pg8::gemm_phase<pg8::EpiGate<1>, pg8::TileOrder, true, true>(F.lds, g, S, E);
#endif
            } else {
                const float* ml = mod + (size_t)L * 9 * MODW; const float* mn = mod + (size_t)(L + 1) * 9 * MODW;
                RN a{X, X + (size_t)MX * DM, last ? F.out : X, X + (size_t)MX * DM, Y, args.out, last ? 0 : 6, ml + 5 * DM, normg + (L * 4 + 3) * DM,
                     last ? nullptr : normg + ((L + 1) * 4 + 0) * DM, last ? nullptr : mn + 1 * DM, last ? nullptr : mn + 0 * DM, last ? nullptr : H, nMrows * 256};
                resnorm_phase(F, a);
            }
        }
        }
        if (((REP >> rcode) & 1) && !rep_done) { rep_done = 1; continue; }
        rep_done = 0;
        if (ph + 1 < args.ph_hi) { if (ph == args.ph_lo) cg::this_grid().sync(); else xcd_barrier(bar); }
        ++ph;
    }
}

#ifndef DIS
#define DIS 0
#endif
#ifndef MK_MULTI
#define MK_MULTI 0
#endif
extern "C" void kernel_launch(void* const* d_in, const int* in_sizes, int n_in, void* d_out, int out_size, void* d_ws, size_t ws_size, hipStream_t stream) {
    static int grid = 0;
    if (grid == 0) {
        if (n_in != 24 || out_size != MX * DM || ws_size < WS_END) { fprintf(stderr, "kernel_launch: unexpected shapes: n_in %d out %d ws %zu (need %zu)\n", n_in, out_size, ws_size, (size_t)WS_END); grid = -1; return; }
        int dev = 0, cus = 0, per_cu = 0;
        if (hipGetDevice(&dev) != hipSuccess || hipDeviceGetAttribute(&cus, hipDeviceAttributeMultiprocessorCount, dev) != hipSuccess) { grid = -1; return; }
        if (hipFuncSetAttribute((const void*)mk_fwd, hipFuncAttributeMaxDynamicSharedMemorySize, LDS_BYTES) != hipSuccess) { fprintf(stderr, "kernel_launch: hipFuncSetAttribute failed\n"); grid = -1; return; }
        if (hipOccupancyMaxActiveBlocksPerMultiprocessor(&per_cu, (const void*)mk_fwd, NWAVES * 64, LDS_BYTES) != hipSuccess || per_cu < 1) { fprintf(stderr, "kernel_launch: occupancy query says %d blocks per CU\n", per_cu); per_cu = 1; }
        (void)hipGetLastError();
        grid = cus;
    }
    if (grid < 0) return;
    if (hipMemsetAsync((char*)d_ws + WS_CTL, 0, 64 * 1024, stream) != hipSuccess) { fprintf(stderr, "kernel_launch: memset failed\n"); return; }
    Args a{};
    for (int i = 0; i < 24; ++i) a.in[i] = (const float*)d_in[i];
    a.out = (float*)d_out; a.ws = (unsigned char*)d_ws;
#if MK_MULTI
    for (int ph = 0; ph < N_PHASES; ++ph) { a.ph_lo = ph; a.ph_hi = ph + 1; hipLaunchKernelGGL(mk_fwd, dim3(grid), dim3(NWAVES * 64), LDS_BYTES, stream, a); }
#else
    a.ph_lo = 0; a.ph_hi = N_PHASES;
    void* kargs[] = {&a};
    hipError_t e = hipLaunchCooperativeKernel((const void*)mk_fwd, dim3(grid), dim3(NWAVES * 64), kargs, LDS_BYTES, stream);
    if (e != hipSuccess) fprintf(stderr, "kernel_launch: cooperative launch failed: %s (grid %d)\n", hipGetErrorString(e), grid);
#endif
}
```
